# Optimizing an MI355X kernel written in HIP

```python
import math
import jax, jax.numpy as jnp
from jax import lax
import numpy as np

D_MODEL = 1024
BATCH = 16
SEQ = 4096
DEPTH = 1

HEAD_DIM = 64
SWA_Q_HEADS = 8
SWA_KV_HEADS = 2
SWA_GROUP = SWA_Q_HEADS // SWA_KV_HEADS
SWA_WINDOW = 128
SWA_BLOCK = 128
MOBA_HEADS = 8
MOBA_BLOCK = 256
MOBA_TOPK = 3
MOBA_QCHUNK = 32
N_BRANCHES = 2
REL_BUCKETS = 32
REL_MAX_DIST = 128
N_REL_HEADS = SWA_Q_HEADS + MOBA_HEADS
N_GROUPS = 4
EXPERTS_PER_GROUP = 8
N_EXPERTS = N_GROUPS * EXPERTS_PER_GROUP
EXPERT_TOPK = 2
D_EXPERT = 512
MOE_BLOCK = 256
LN_EPS = 1e-5
DEEPNORM_ALPHA = (2.0 * DEPTH) ** 0.25
DEEPNORM_BETA = (8.0 * DEPTH) ** -0.25
NEG_INF = -1e30
ATTN_SCALE = HEAD_DIM ** -0.5

SWA_Q_W = SWA_Q_HEADS * HEAD_DIM
SWA_KV_W = SWA_KV_HEADS * HEAD_DIM
MOBA_W = MOBA_HEADS * HEAD_DIM
GATE_W = N_BRANCHES * D_MODEL
OFF_SWA_Q = 0
OFF_SWA_K = OFF_SWA_Q + SWA_Q_W
OFF_SWA_V = OFF_SWA_K + SWA_KV_W
OFF_MOBA_Q = OFF_SWA_V + SWA_KV_W
OFF_MOBA_K = OFF_MOBA_Q + MOBA_W
OFF_MOBA_V = OFF_MOBA_K + MOBA_W
OFF_GATE = OFF_MOBA_V + MOBA_W
D_IN_PROJ = OFF_GATE + GATE_W

kernel_name = "hybrid_swa_sinks_moba_gated_deepnorm_hmoe"


def layer_norm(x, gain, bias):
    xf = x.astype(jnp.float32)
    mu = jnp.mean(xf, axis=-1, keepdims=True)
    var = jnp.mean(jnp.square(xf - mu), axis=-1, keepdims=True)
    y = (xf - mu) * lax.rsqrt(var + LN_EPS) * gain.astype(jnp.float32) + bias.astype(jnp.float32)
    return y.astype(x.dtype)


def rel_bucket(dist):
    n = jnp.maximum(dist, 0)
    max_exact = REL_BUCKETS // 2
    nf = jnp.maximum(n, 1).astype(jnp.float32)
    large = max_exact + (jnp.log(nf / max_exact) / math.log(REL_MAX_DIST / max_exact)
                         * (REL_BUCKETS - max_exact)).astype(jnp.int32)
    large = jnp.minimum(large, REL_BUCKETS - 1)
    return jnp.where(n < max_exact, n, large)


def sliding_window_attention(q, k, v, sinks, rel_table_a):
    B, S, _ = q.shape
    nb = S // SWA_BLOCK
    q = q.reshape(B, nb, SWA_BLOCK, SWA_KV_HEADS, SWA_GROUP, HEAD_DIM)
    k = k.reshape(B, nb, SWA_BLOCK, SWA_KV_HEADS, HEAD_DIM)
    v = v.reshape(B, nb, SWA_BLOCK, SWA_KV_HEADS, HEAD_DIM)
    pad = jnp.zeros_like(k[:, :1])
    k_cat = jnp.concatenate([jnp.concatenate([pad, k[:, :-1]], axis=1), k], axis=2)
    v_cat = jnp.concatenate([jnp.concatenate([pad, v[:, :-1]], axis=1), v], axis=2)
    logits = jnp.einsum('bnqkgd,bnskd->bnkgqs', q, k_cat).astype(jnp.float32) * ATTN_SCALE
    qi = jnp.arange(SWA_BLOCK)
    kj = jnp.arange(2 * SWA_BLOCK)
    dist = SWA_BLOCK + qi[:, None] - kj[None, :]
    bias = rel_table_a.astype(jnp.float32)[rel_bucket(dist)]
    bias = bias.reshape(SWA_BLOCK, 2 * SWA_BLOCK, SWA_KV_HEADS, SWA_GROUP).transpose(2, 3, 0, 1)
    k_abs = jnp.arange(nb)[:, None] * SWA_BLOCK - SWA_BLOCK + kj[None, :]
    visible = ((dist >= 0) & (dist < SWA_WINDOW))[None] & (k_abs >= 0)[:, None, :]
    logits = jnp.where(visible[None, :, None, None], logits + bias[None, None], NEG_INF)
    sink = jnp.broadcast_to(
        sinks.astype(jnp.float32).reshape(SWA_KV_HEADS, SWA_GROUP)[None, None, :, :, None, None],
        logits.shape[:-1] + (1,))
    probs = jax.nn.softmax(jnp.concatenate([logits, sink], axis=-1), axis=-1)[..., :-1]
    out = jnp.einsum('bnkgqs,bnskd->bnqkgd', probs.astype(v.dtype), v_cat)
    return out.reshape(B, S, SWA_Q_W)


def moba_attention(q, k, v, rel_table_b):
    B, S, _ = q.shape
    nb = -(-S // MOBA_BLOCK)
    s_pad = nb * MOBA_BLOCK

    def heads(t):
        t = jnp.pad(t, ((0, 0), (0, s_pad - S), (0, 0)))
        return t.reshape(B, s_pad, MOBA_HEADS, HEAD_DIM).transpose(0, 2, 1, 3)

    q, k, v = heads(q), heads(k), heads(v)
    kb = k.reshape(B, MOBA_HEADS, nb, MOBA_BLOCK, HEAD_DIM)
    vb = v.reshape(B, MOBA_HEADS, nb, MOBA_BLOCK, HEAD_DIM)
    k_mean = jnp.mean(kb, axis=3)
    q_blk = jnp.arange(s_pad) // MOBA_BLOCK
    gate = jnp.einsum('bhsd,bhnd->bhsn', q, k_mean).astype(jnp.float32)
    past = jnp.arange(nb)[None, :] < q_blk[:, None]
    gate = jnp.where(past, gate, NEG_INF)
    k_sel = min(MOBA_TOPK, nb)
    _, top_idx = lax.top_k(gate, k_sel)
    sel_valid = jnp.arange(k_sel)[None, :] < q_blk[:, None]
    b_ix = jnp.arange(B)[:, None, None, None]
    h_ix = jnp.arange(MOBA_HEADS)[None, :, None, None]
    table_h = rel_table_b.astype(jnp.float32).T

    def one_chunk(c):
        start = c * MOBA_QCHUNK
        qc = lax.dynamic_slice_in_dim(q, start, MOBA_QCHUNK, axis=2)
        idx = lax.dynamic_slice_in_dim(top_idx, start, MOBA_QCHUNK, axis=2)
        valid = lax.dynamic_slice_in_dim(sel_valid, start, MOBA_QCHUNK, axis=0)
        blk = start // MOBA_BLOCK
        k_own = lax.dynamic_index_in_dim(kb, blk, axis=2, keepdims=False)
        v_own = lax.dynamic_index_in_dim(vb, blk, axis=2, keepdims=False)
        k_g = kb[b_ix, h_ix, idx]
        v_g = vb[b_ix, h_ix, idx]
        q_pos = start + jnp.arange(MOBA_QCHUNK)
        d_own = q_pos[:, None] - (blk * MOBA_BLOCK + jnp.arange(MOBA_BLOCK))[None, :]
        l_own = jnp.einsum('bhcd,bhtd->bhct', qc, k_own).astype(jnp.float32) * ATTN_SCALE
        l_own = jnp.where(d_own >= 0, l_own + table_h[:, rel_bucket(d_own)][None], NEG_INF)
        sel_pos = idx[..., None] * MOBA_BLOCK + jnp.arange(MOBA_BLOCK)
        d_sel = q_pos[None, None, :, None, None] - sel_pos
        l_sel = jnp.einsum('bhcd,bhcktd->bhckt', qc, k_g).astype(jnp.float32) * ATTN_SCALE
        l_sel = l_sel + table_h[h_ix[..., None], rel_bucket(d_sel)]
        l_sel = jnp.where(valid[None, None, :, :, None], l_sel, NEG_INF)
        logits = jnp.concatenate([l_own, l_sel.reshape(B, MOBA_HEADS, MOBA_QCHUNK, k_sel * MOBA_BLOCK)], axis=-1)
        p = jax.nn.softmax(logits, axis=-1).astype(v.dtype)
        p_own = p[..., :MOBA_BLOCK]
        p_sel = p[..., MOBA_BLOCK:].reshape(B, MOBA_HEADS, MOBA_QCHUNK, k_sel, MOBA_BLOCK)
        return (jnp.einsum('bhct,bhtd->bhcd', p_own, v_own)
                + jnp.einsum('bhckt,bhcktd->bhcd', p_sel, v_g))

    out = lax.map(one_chunk, jnp.arange(s_pad // MOBA_QCHUNK))
    out = out.transpose(1, 0, 3, 2, 4).reshape(B, s_pad, MOBA_W)
    return out[:, :S]


def hierarchical_moe(h, w_group, b_group, w_expert, b_expert, w_gate, w_up, w_down):
    B, S, D = h.shape
    T = B * S
    hf = h.reshape(T, D)
    g_logits = (hf @ w_group + b_group).astype(jnp.float32)
    g_idx = jnp.argmax(g_logits, axis=-1)
    g_prob = jnp.take_along_axis(jax.nn.softmax(g_logits, axis=-1), g_idx[:, None], axis=1)
    e_logits = (hf @ w_expert + b_expert).astype(jnp.float32).reshape(T, N_GROUPS, EXPERTS_PER_GROUP)
    e_logits = jnp.take_along_axis(e_logits, g_idx[:, None, None], axis=1)[:, 0]
    e_top, e_loc = lax.top_k(e_logits, EXPERT_TOPK)
    weights = g_prob * jax.nn.softmax(e_top, axis=-1)
    flat_e = (g_idx[:, None] * EXPERTS_PER_GROUP + e_loc).reshape(-1)
    flat_w = weights.reshape(-1)
    n_assign = T * EXPERT_TOPK
    order = jnp.argsort(flat_e)
    sorted_e = flat_e[order]
    tok = order // EXPERT_TOPK
    sizes = jnp.bincount(flat_e, length=N_EXPERTS)
    start_unpadded = jnp.cumsum(sizes) - sizes
    padded = ((sizes + MOE_BLOCK - 1) // MOE_BLOCK) * MOE_BLOCK
    padded_end = jnp.cumsum(padded)
    padded_start = padded_end - padded
    dest = padded_start[sorted_e] + jnp.arange(n_assign) - start_unpadded[sorted_e]
    cap = -(-n_assign // MOE_BLOCK) * MOE_BLOCK + N_EXPERTS * MOE_BLOCK
    n_blocks = cap // MOE_BLOCK
    x_buf = jnp.zeros((cap, D), h.dtype).at[dest].set(hf[tok])
    blk_expert = jnp.minimum(
        jnp.searchsorted(padded_end, jnp.arange(n_blocks) * MOE_BLOCK, side='right'), N_EXPERTS - 1)

    def expert_block(args):
        xb, e = args
        act = jax.nn.silu(xb @ w_gate[e]) * (xb @ w_up[e])
        return act @ w_down[e]

    y_buf = lax.map(expert_block, (x_buf.reshape(n_blocks, MOE_BLOCK, D), blk_expert)).reshape(cap, D)
    contrib = y_buf[dest] * flat_w[order][:, None].astype(h.dtype)
    y = jnp.zeros_like(hf).at[tok].add(contrib)
    return y.reshape(B, S, D)


def setup_inputs(seed: int = 0) -> dict:
    key = jax.random.key(seed)
    ks = jax.random.split(key, 24)
    f32 = jnp.float32

    def nrm(k, shape, scale):
        return jax.random.normal(k, shape, f32) * scale

    s_d = D_MODEL ** -0.5
    beta = DEEPNORM_BETA
    x = jax.random.normal(ks[0], (BATCH, SEQ, D_MODEL), f32)
    w_in = jnp.concatenate([
        nrm(ks[1], (DEPTH, D_MODEL, SWA_Q_W), s_d),
        nrm(ks[2], (DEPTH, D_MODEL, SWA_KV_W), s_d),
        nrm(ks[3], (DEPTH, D_MODEL, SWA_KV_W), s_d * beta),
        nrm(ks[4], (DEPTH, D_MODEL, MOBA_W), s_d),
        nrm(ks[5], (DEPTH, D_MODEL, MOBA_W), s_d),
        nrm(ks[6], (DEPTH, D_MODEL, MOBA_W), s_d * beta),
        nrm(ks[7], (DEPTH, D_MODEL, GATE_W), s_d),
    ], axis=-1)
    b_in = nrm(ks[8], (DEPTH, D_IN_PROJ), 0.02)
    attn_sinks = nrm(ks[9], (DEPTH, SWA_Q_HEADS), 0.5)
    rel_bias_table = nrm(ks[10], (REL_BUCKETS, N_REL_HEADS), 0.2)
    w_branch_swa = nrm(ks[11], (DEPTH, SWA_Q_W, D_MODEL), SWA_Q_W ** -0.5 * beta)
    w_branch_moba = nrm(ks[12], (DEPTH, MOBA_W, D_MODEL), MOBA_W ** -0.5 * beta)
    w_out = nrm(ks[13], (DEPTH, D_MODEL, D_MODEL), s_d * beta)
    ln1_gain = 1.0 + nrm(ks[14], (DEPTH, D_MODEL), 0.02)
    ln1_bias = nrm(ks[15], (DEPTH, D_MODEL), 0.02)
    w_group_router = nrm(ks[16], (DEPTH, D_MODEL, N_GROUPS), s_d)
    b_group_router = nrm(ks[17], (DEPTH, N_GROUPS), 0.01)
    w_expert_router = nrm(ks[18], (DEPTH, D_MODEL, N_EXPERTS), s_d)
    b_expert_router = nrm(ks[19], (DEPTH, N_EXPERTS), 0.01)
    w_expert_gate = nrm(ks[20], (DEPTH, N_EXPERTS, D_MODEL, D_EXPERT), s_d * beta)
    w_expert_up = nrm(ks[21], (DEPTH, N_EXPERTS, D_MODEL, D_EXPERT), s_d * beta)
    w_expert_down = nrm(ks[22], (DEPTH, N_EXPERTS, D_EXPERT, D_MODEL), D_EXPERT ** -0.5 * beta)
    k_ln = jax.random.split(ks[23], 2)
    ln2_gain = 1.0 + nrm(k_ln[0], (DEPTH, D_MODEL), 0.02)
    ln2_bias = nrm(k_ln[1], (DEPTH, D_MODEL), 0.02)
    return {"x": x, "w_in": w_in, "b_in": b_in, "attn_sinks": attn_sinks,
            "rel_bias_table": rel_bias_table, "w_branch_swa": w_branch_swa,
            "w_branch_moba": w_branch_moba, "w_out": w_out, "ln1_gain": ln1_gain,
            "ln1_bias": ln1_bias, "w_group_router": w_group_router,
            "b_group_router": b_group_router, "w_expert_router": w_expert_router,
            "b_expert_router": b_expert_router, "w_expert_gate": w_expert_gate,
            "w_expert_up": w_expert_up, "w_expert_down": w_expert_down,
            "ln2_gain": ln2_gain, "ln2_bias": ln2_bias}


def reference(x, w_in, b_in, attn_sinks, rel_bias_table, w_branch_swa, w_branch_moba, w_out,
              ln1_gain, ln1_bias, w_group_router, b_group_router, w_expert_router, b_expert_router,
              w_expert_gate, w_expert_up, w_expert_down, ln2_gain, ln2_bias):
    rel_a = rel_bias_table[:, :SWA_Q_HEADS]
    rel_b = rel_bias_table[:, SWA_Q_HEADS:]
    for layer in range(DEPTH):
        proj = x @ w_in[layer] + b_in[layer]
        y_a = sliding_window_attention(proj[..., OFF_SWA_Q:OFF_SWA_K], proj[..., OFF_SWA_K:OFF_SWA_V],
                                       proj[..., OFF_SWA_V:OFF_MOBA_Q], attn_sinks[layer], rel_a)
        y_b = moba_attention(proj[..., OFF_MOBA_Q:OFF_MOBA_K], proj[..., OFF_MOBA_K:OFF_MOBA_V],
                             proj[..., OFF_MOBA_V:OFF_GATE], rel_b)
        gates = jax.nn.sigmoid(proj[..., OFF_GATE:])
        merged = (gates[..., :D_MODEL] * (y_a @ w_branch_swa[layer])
                  + gates[..., D_MODEL:] * (y_b @ w_branch_moba[layer]))
        mixed = merged @ w_out[layer]
        x = layer_norm(DEEPNORM_ALPHA * x + mixed, ln1_gain[layer], ln1_bias[layer])
        moe = hierarchical_moe(x, w_group_router[layer], b_group_router[layer], w_expert_router[layer],
                               b_expert_router[layer], w_expert_gate[layer], w_expert_up[layer],
                               w_expert_down[layer])
        x = layer_norm(DEEPNORM_ALPHA * x + moe, ln2_gain[layer], ln2_bias[layer])
    return x
```

```cpp
#include <hip/hip_runtime.h>
#include <cstdio>
#include <cstdint>

#define GAS __attribute__((address_space(1)))
#define LAS __attribute__((address_space(3)))
typedef unsigned short bf16_t;
typedef short bf16x8 __attribute__((ext_vector_type(8)));
typedef float f32x4 __attribute__((ext_vector_type(4)));
typedef float f32x2 __attribute__((ext_vector_type(2)));
typedef unsigned u32x4 __attribute__((ext_vector_type(4)));
typedef unsigned u32x2 __attribute__((ext_vector_type(2)));

#ifndef PROBE_ATTN
#define PROBE_ATTN 0
#endif
#define PROBE_AMP 1.0f
#define PROBE_LO 0
#define PROBE_HI 1024
#ifndef DUP_PHASE
#define DUP_PHASE -1
#endif
#ifndef MK_N_LAUNCHES
#define MK_N_LAUNCHES 1
#endif

constexpr int NBATCH = 16, SEQ = 4096, DM = 1024, MTOK = NBATCH * SEQ;
constexpr int NPROJ = 4352, NQKV = 2304, NGATE = 2048;
constexpr int QS_OFF = 0, KS_OFF = 512, VS_OFF = 640, QM_OFF = 768, KM_OFF = 1280, VM_OFF = 1792;
constexpr int NEXP = 32, DEXP = 512;
constexpr float LN_EPS = 1e-5f;
constexpr float ALPHA = 1.1892071150027210667f;
constexpr float LOG2E = 1.4426950408889634f;
constexpr float C2 = 0.125f * 1.4426950408889634f;
constexpr int NPHASE = 10;

constexpr size_t MiB = 1u << 20;
constexpr size_t WS_CTL = 0, CTL_ZERO_BYTES = 128 * 1024;
constexpr size_t WS_WIN_T = 2 * MiB;
constexpr size_t WS_WA_T = 11 * MiB;
constexpr size_t WS_WB_T = 12 * MiB;
constexpr size_t WS_WO_T = 13 * MiB;
constexpr size_t WS_WR_T = 15 * MiB;
constexpr size_t WS_GU_T = 16 * MiB;
constexpr size_t WS_WD_T = 80 * MiB;
constexpr size_t WS_LIST = 112 * MiB;
constexpr size_t WS_KMEAN = 96 * MiB;
constexpr size_t WS_R1 = 128 * MiB;
constexpr size_t WS_R2 = 256 * MiB;
constexpr size_t WS_R3 = 544 * MiB;
constexpr size_t WS_X1F8 = 800 * MiB;
constexpr size_t WS_PROBE = 864 * MiB;
constexpr size_t WS_END = PROBE_ATTN ? 992 * MiB : 864 * MiB;
constexpr int CW_BAR = 4096;
constexpr int CW_CNT = 16384;

constexpr int RING_BYTES = 131072;
constexpr int LDSCTL_OFF = RING_BYTES, MISC_OFF = LDSCTL_OFF + 320;
constexpr int MOE_OFF = LDSCTL_OFF + 1024;
constexpr int EPI_STG_OFF = LDSCTL_OFF + 2048, EPI_STG_WAVE = 2304;
constexpr int LDS_BYTES = EPI_STG_OFF + 8 * EPI_STG_WAVE;

#define RLX_AGENT __ATOMIC_RELAXED, __HIP_MEMORY_SCOPE_AGENT
__device__ __forceinline__ unsigned cvt_pk_bf16(float lo, float hi) { unsigned r; asm volatile("v_cvt_pk_bf16_f32 %0, %1, %2" : "=v"(r) : "v"(lo), "v"(hi)); return r; }
__device__ __forceinline__ float clampf(float v, float lo, float hi) { return __builtin_amdgcn_fmed3f(v, lo, hi); }
__device__ __forceinline__ unsigned pk4_fp8(float a, float b, float c, float d) { int w = __builtin_amdgcn_cvt_pk_fp8_f32(a, b, 0, false); w = __builtin_amdgcn_cvt_pk_fp8_f32(c, d, w, true); return (unsigned)w; }
__device__ __forceinline__ float fp8_at(int w, int j) { return j == 0 ? __builtin_amdgcn_cvt_f32_fp8(w, 0) : j == 1 ? __builtin_amdgcn_cvt_f32_fp8(w, 1) : j == 2 ? __builtin_amdgcn_cvt_f32_fp8(w, 2) : __builtin_amdgcn_cvt_f32_fp8(w, 3); }
__device__ __forceinline__ float bf_lo(unsigned w) { return __uint_as_float(w << 16); }
__device__ __forceinline__ float bf_hi(unsigned w) { return __uint_as_float(w & 0xffff0000u); }
__device__ __forceinline__ float bf1(bf16_t b) { return __uint_as_float((unsigned)b << 16); }
template <class T> __device__ __forceinline__ T ldnt(const T* p) { return __builtin_nontemporal_load(p); }
template <class T> __device__ __forceinline__ void stnt(T* p, T v) { __builtin_nontemporal_store(v, p); }
__device__ __forceinline__ void st_wt16(void* p, u32x4 v) { asm volatile("global_store_dwordx4 %0, %1, off sc0 sc1\n\ts_nop 1" :: "v"(p), "v"(v) : "memory"); }
__device__ __forceinline__ float wave_sum(float v) {
    v += __builtin_bit_cast(float, __builtin_amdgcn_update_dpp(0, __builtin_bit_cast(int, v), 0xB1, 0xF, 0xF, true));
    v += __builtin_bit_cast(float, __builtin_amdgcn_update_dpp(0, __builtin_bit_cast(int, v), 0x4E, 0xF, 0xF, true));
    v += __builtin_bit_cast(float, __builtin_amdgcn_update_dpp(0, __builtin_bit_cast(int, v), 0x141, 0xF, 0xF, true));
    v += __builtin_bit_cast(float, __builtin_amdgcn_update_dpp(0, __builtin_bit_cast(int, v), 0x140, 0xF, 0xF, true));
    const float r0 = __builtin_bit_cast(float, __builtin_amdgcn_readlane(__builtin_bit_cast(int, v), 0)), r1 = __builtin_bit_cast(float, __builtin_amdgcn_readlane(__builtin_bit_cast(int, v), 16)),
                r2 = __builtin_bit_cast(float, __builtin_amdgcn_readlane(__builtin_bit_cast(int, v), 32)), r3 = __builtin_bit_cast(float, __builtin_amdgcn_readlane(__builtin_bit_cast(int, v), 48));
    return (r0 + r1) + (r2 + r3);
}
__device__ __forceinline__ float row16_sum(float v) {
    v += __builtin_bit_cast(float, __builtin_amdgcn_update_dpp(0, __builtin_bit_cast(int, v), 0xB1, 0xF, 0xF, true));
    v += __builtin_bit_cast(float, __builtin_amdgcn_update_dpp(0, __builtin_bit_cast(int, v), 0x4E, 0xF, 0xF, true));
    v += __builtin_bit_cast(float, __builtin_amdgcn_update_dpp(0, __builtin_bit_cast(int, v), 0x141, 0xF, 0xF, true));
    v += __builtin_bit_cast(float, __builtin_amdgcn_update_dpp(0, __builtin_bit_cast(int, v), 0x140, 0xF, 0xF, true));
    return v;
}
__device__ __forceinline__ float wave_max(float v) {
#pragma unroll
    for (int o = 1; o < 64; o <<= 1) v = fmaxf(v, __shfl_xor(v, o));
    return v;
}

namespace pg8 {
constexpr int BM = 256, BK = 64, HALF = 128, HTB = HALF * BK * 2, STAGE_BYTES = 8 * HTB, NXCD = 8, WGM = 8;
__host__ __device__ __forceinline__ int lds_byte(int r, int c) { const int st = (r >> 4) * 2 + (c >> 5), rr = r & 15, cc = c & 31, ob = rr * 64 + cc * 2; return st * 1024 + (ob ^ (((ob >> 9) & 1) << 5)); }
__host__ __device__ __forceinline__ void stage_rc(int b, int& R, int& C) { const int st = b / 1024, sb = b % 1024, swz = sb ^ (((sb >> 9) & 1) << 5); R = (st >> 1) * 16 + swz / 64; C = (st & 1) * 32 + (swz % 64) / 2; }
__host__ __device__ __forceinline__ int perm32(int rho) { const int n = rho >> 4, i = rho & 15; return 8 * (i >> 2) + 4 * n + (i & 3); }
__host__ __device__ __forceinline__ int perm128(int R) { return 64 * (R >> 5) + 16 * ((R & 15) >> 2) + 4 * ((R >> 4) & 1) + (R & 3); }

struct Unit { int pm, pn, aux, aux2; };
typedef int v4i __attribute__((ext_vector_type(4))); typedef int v8i __attribute__((ext_vector_type(8)));
__device__ __forceinline__ void mma8_fp8(f32x4 (&c)[4][2], const v8i (&A)[4], const v8i (&B)[2], int sw, int sx) {
    asm volatile("s_nop 1\n\t"
        "v_mfma_scale_f32_16x16x128_f8f6f4 %0, %12, %8, %0, %14, %15 op_sel_hi:[0,0,0]\n\t"
        "v_mfma_scale_f32_16x16x128_f8f6f4 %1, %13, %8, %1, %14, %15 op_sel_hi:[0,0,0]\n\t"
        "v_mfma_scale_f32_16x16x128_f8f6f4 %2, %12, %9, %2, %14, %15 op_sel_hi:[0,0,0]\n\t"
        "v_mfma_scale_f32_16x16x128_f8f6f4 %3, %13, %9, %3, %14, %15 op_sel_hi:[0,0,0]\n\t"
        "v_mfma_scale_f32_16x16x128_f8f6f4 %4, %12, %10, %4, %14, %15 op_sel_hi:[0,0,0]\n\t"
        "v_mfma_scale_f32_16x16x128_f8f6f4 %5, %13, %10, %5, %14, %15 op_sel_hi:[0,0,0]\n\t"
        "v_mfma_scale_f32_16x16x128_f8f6f4 %6, %12, %11, %6, %14, %15 op_sel_hi:[0,0,0]\n\t"
        "v_mfma_scale_f32_16x16x128_f8f6f4 %7, %13, %11, %7, %14, %15 op_sel_hi:[0,0,0]"
        : "+v"(c[0][0]), "+v"(c[0][1]), "+v"(c[1][0]), "+v"(c[1][1]), "+v"(c[2][0]), "+v"(c[2][1]), "+v"(c[3][0]), "+v"(c[3][1])
        : "v"(A[0]), "v"(A[1]), "v"(A[2]), "v"(A[3]), "v"(B[0]), "v"(B[1]), "v"(sw), "v"(sx));
}
template <bool NOPS> __device__ __forceinline__ void mma_settle(f32x4 (&c)[4][2]) {
    if constexpr (NOPS) asm volatile("s_nop 15\n\ts_nop 7" : "+v"(c[0][0]), "+v"(c[0][1]), "+v"(c[1][0]), "+v"(c[1][1]), "+v"(c[2][0]), "+v"(c[2][1]), "+v"(c[3][0]), "+v"(c[3][1]));
    else asm volatile("" : "+v"(c[0][0]), "+v"(c[0][1]), "+v"(c[1][0]), "+v"(c[1][1]), "+v"(c[2][0]), "+v"(c[2][1]), "+v"(c[3][0]), "+v"(c[3][1]));
}
template <int H> __device__ __forceinline__ bf16x8 half8(v8i x) { return __builtin_bit_cast(bf16x8, (v4i)(H ? __builtin_shufflevector(x, x, 4, 5, 6, 7) : __builtin_shufflevector(x, x, 0, 1, 2, 3))); }
__device__ __forceinline__ v8i cat8(bf16x8 a, bf16x8 b) { const v4i x = __builtin_bit_cast(v4i, a), y = __builtin_bit_cast(v4i, b); return __builtin_shufflevector(x, y, 0, 1, 2, 3, 4, 5, 6, 7); }

struct StaticOrder {
    int nM, nN, nwg, G, c;
    __device__ void init(int M, int N, int G_, int c_) { nM = M / BM; nN = N / BM; nwg = nM * nN; G = G_; c = c_; }
    __device__ bool next(int i, Unit& u) const {
        const long L = (long)i * G + c; if (L >= nwg) return false;
        int wgid = (int)L; { const int q = nwg / NXCD, r = nwg % NXCD, xcd = wgid % NXCD, off = wgid / NXCD; wgid = (xcd < r ? xcd * (q + 1) : r * (q + 1) + (xcd - r) * q) + off; }
        const int nig = WGM * nN, gid = wgid / nig, fm = gid * WGM, gsz = (nM - fm) < WGM ? (nM - fm) : WGM;
        u.pm = fm + ((wgid % nig) % gsz); u.pn = (wgid % nig) / gsz; u.aux = 0; u.aux2 = 0; return true;
    }
};

template <class P>
__device__ __forceinline__ void gemm_phase(LAS unsigned char* lds, const P& p) {
    const int tid = threadIdx.x, wid = __builtin_amdgcn_readfirstlane(tid >> 6), lane = tid & 63, wr = wid >> 2, wc = wid & 3, fr = lane & 15, fq = lane >> 4;
    constexpr bool FP8 = P::FP8;
    const int KB = p.KB, nt = KB / 128;
    unsigned voffB[2]; int stR[2], stC2[2];
#pragma unroll
    for (int i = 0; i < 2; ++i) { int R, C; stage_rc(tid * 16 + i * 8192, R, C); const int Rb = (int)P::PERM == 2 ? perm128(R) : (int)P::PERM == 1 ? ((R & ~31) + perm32(R & 31)) : R;
        voffB[i] = (unsigned)(Rb * KB + C * 2); stR[i] = R; stC2[i] = C * 2; }
    const size_t kstep = (size_t)(BK * 2);
    const size_t hstepB = (size_t)((int)P::PERM == 2 ? 8 : HALF) * KB;
    const unsigned ldsw = (unsigned)wid * 1024u;
    const int aoff = lds_byte(wr * 64 + fr, fq * 8), boff = lds_byte(wc * 32 + fr, fq * 8);
#define PG8_SA(b, h) (((b) * 2 + (h)) * HTB)
#define PG8_SB(b, h) ((4 + (b) * 2 + (h)) * HTB)
#define PG8_STAGE(bufoff, gbase, voff) do { _Pragma("unroll") for (int _i = 0; _i < 2; ++_i) \
        __builtin_amdgcn_global_load_lds((const unsigned*)((const char*)(gbase) + (voff)[_i]), (LAS unsigned*)(lds + (bufoff) + ldsw + _i * 8192), 16, 0, 0); } while (0)
#define PG8_LDA(dst, b, h) do { _Pragma("unroll") for (int m = 0; m < 4; ++m) dst[m] = cat8(*(const LAS bf16x8*)(lds + PG8_SA(b, h) + aoff + m * 2048), *(const LAS bf16x8*)(lds + PG8_SA(b, h) + aoff + m * 2048 + 1024)); } while (0)
#define PG8_LDB(dst, b, h) do { _Pragma("unroll") for (int n = 0; n < 2; ++n) dst[n] = cat8(*(const LAS bf16x8*)(lds + PG8_SB(b, h) + boff + n * 2048), *(const LAS bf16x8*)(lds + PG8_SB(b, h) + boff + n * 2048 + 1024)); } while (0)
#define PG8_MMA(ai, bj, At, Bt) do { __builtin_amdgcn_s_setprio(1); if constexpr (FP8) mma8_fp8(acc[ai][bj], At, Bt, sc_w, sc_x); else _Pragma("unroll") for (int m = 0; m < 4; ++m) _Pragma("unroll") for (int n = 0; n < 2; ++n) { \
        if constexpr (FP8) {} \
        else { acc[ai][bj][m][n] = __builtin_amdgcn_mfma_f32_16x16x32_bf16(half8<0>(Bt[n]), half8<0>(At[m]), acc[ai][bj][m][n], 0, 0, 0); \
               acc[ai][bj][m][n] = __builtin_amdgcn_mfma_f32_16x16x32_bf16(half8<1>(Bt[n]), half8<1>(At[m]), acc[ai][bj][m][n], 0, 0, 0); } } \
        __builtin_amdgcn_s_setprio(0); } while (0)
#define PG8_WAIT_V(n) asm volatile("s_waitcnt vmcnt(" #n ")" ::: "memory")
#define PG8_WAIT_L(n) asm volatile("s_waitcnt lgkmcnt(" #n ")" ::: "memory")
#define PG8_BAR __builtin_amdgcn_s_barrier()
#define PG8_SCHED __builtin_amdgcn_sched_barrier(0)
#define PG8_AOFF(dst, u) do { _Pragma("unroll") for (int _h = 0; _h < 2; ++_h) _Pragma("unroll") for (int _i = 0; _i < 2; ++_i) dst[_h][_i] = p.a_rowoff(u, _h * HALF + stR[_i]) + (unsigned)stC2[_i]; } while (0)
    Unit cur, nxt; int ui = 0;
    if (!p.next(0, cur)) return;
    f32x4 acc[2][2][4][2];
#pragma unroll
    for (int a = 0; a < 2; ++a)
#pragma unroll
        for (int b = 0; b < 2; ++b)
#pragma unroll
            for (int m = 0; m < 4; ++m)
#pragma unroll
                for (int n = 0; n < 2; ++n) acc[a][b][m][n] = (f32x4){0.f, 0.f, 0.f, 0.f};
    int sc_w = P::SCALE, sc_x = 0x7f7f7f7f; asm volatile("" : "+v"(sc_w), "+v"(sc_x));
    v8i At[4], B0[2], B1[2];
    unsigned oc[2][2], on[2][2];
    PG8_AOFF(oc, cur);
    const char* const aB = p.A;
    const char* cB = p.b_ptr(cur);
    PG8_STAGE(PG8_SB(0, 0), cB, voffB); PG8_STAGE(PG8_SB(0, 1), cB + hstepB, voffB); PG8_STAGE(PG8_SA(0, 0), aB, oc[0]); PG8_STAGE(PG8_SA(0, 1), aB, oc[1]);
    if (wr == 1) PG8_BAR;
    PG8_WAIT_V(2); PG8_BAR;
    PG8_STAGE(PG8_SB(1, 0), cB + kstep, voffB); PG8_STAGE(PG8_SA(1, 0), aB + kstep, oc[0]); PG8_STAGE(PG8_SB(1, 1), cB + hstepB + kstep, voffB);
    PG8_WAIT_V(6); PG8_BAR;
    for (;;) {
        const bool has_next = p.next(ui + 1, nxt);
        const char* nB = cB;
        if (has_next) { PG8_AOFF(on, nxt); nB = p.b_ptr(nxt); }
        else {
#pragma unroll
            for (int h = 0; h < 2; ++h)
#pragma unroll
                for (int i = 0; i < 2; ++i) on[h][i] = oc[h][i];
        }
        for (int t = 0; t < nt; t += 2) {
            const bool last = (t == nt - 2);
            const char* a1 = aB + (size_t)(t + 1) * kstep;
            const char* a2 = last ? aB : aB + (size_t)(t + 2) * kstep; const char* b2 = last ? nB : cB + (size_t)(t + 2) * kstep;
            const char* a3 = a2 + kstep; const char* b3 = b2 + kstep;
            unsigned o2[2][2];
#pragma unroll
            for (int h = 0; h < 2; ++h)
#pragma unroll
                for (int i = 0; i < 2; ++i) o2[h][i] = last ? on[h][i] : oc[h][i];
            PG8_LDB(B0, 0, 0); PG8_LDB(B1, 0, 1); PG8_SCHED; PG8_LDA(At, 0, 0); PG8_STAGE(PG8_SA(1, 1), a1, oc[1]);
            PG8_WAIT_V(8); PG8_WAIT_L(0); PG8_BAR; PG8_MMA(0, 0, At, B0); PG8_MMA(0, 1, At, B1); PG8_BAR; PG8_SCHED;
            PG8_LDA(At, 0, 1); PG8_STAGE(PG8_SB(0, 0), b2, voffB); PG8_STAGE(PG8_SB(0, 1), b2 + hstepB, voffB); PG8_STAGE(PG8_SA(0, 0), a2, o2[0]);
            PG8_WAIT_V(8); PG8_WAIT_L(0); PG8_BAR; PG8_MMA(1, 0, At, B0); PG8_MMA(1, 1, At, B1); PG8_BAR; PG8_SCHED;
            PG8_LDB(B0, 1, 0); PG8_LDB(B1, 1, 1); PG8_SCHED; PG8_LDA(At, 1, 0); PG8_STAGE(PG8_SA(0, 1), a2, o2[1]);
            PG8_WAIT_V(8); PG8_WAIT_L(0); PG8_BAR; PG8_MMA(0, 0, At, B0); PG8_MMA(0, 1, At, B1); PG8_BAR; PG8_SCHED;
            PG8_LDA(At, 1, 1); PG8_STAGE(PG8_SB(1, 0), b3, voffB); PG8_STAGE(PG8_SB(1, 1), b3 + hstepB, voffB); PG8_STAGE(PG8_SA(1, 0), a3, o2[0]);
            PG8_WAIT_V(8); PG8_WAIT_L(0); PG8_BAR; PG8_MMA(1, 0, At, B0); PG8_MMA(1, 1, At, B1); PG8_BAR; PG8_SCHED;
        }
        if (wr == 0) PG8_BAR;
        if constexpr (FP8) { mma_settle<true>(acc[0][0]); mma_settle<false>(acc[0][1]); mma_settle<false>(acc[1][0]); mma_settle<false>(acc[1][1]); }
        const bool fin = p.epi(acc, cur, wr, wc, fr, fq, lds + EPI_STG_OFF + wid * EPI_STG_WAVE);
        if (!has_next) break;
        if (fin) {
#pragma unroll
            for (int a = 0; a < 2; ++a)
#pragma unroll
                for (int b = 0; b < 2; ++b)
#pragma unroll
                    for (int m = 0; m < 4; ++m)
#pragma unroll
                        for (int n = 0; n < 2; ++n) acc[a][b][m][n] = (f32x4){0.f, 0.f, 0.f, 0.f};
        }
        cur = nxt; cB = nB; ++ui;
#pragma unroll
        for (int h = 0; h < 2; ++h)
#pragma unroll
            for (int i = 0; i < 2; ++i) oc[h][i] = on[h][i];
        if (wr == 1) PG8_BAR;
    }
    PG8_WAIT_V(0);
    PG8_BAR;
#undef PG8_SA
#undef PG8_SB
#undef PG8_STAGE
#undef PG8_LDA
#undef PG8_LDB
#undef PG8_MMA
#undef PG8_WAIT_V
#undef PG8_WAIT_L
#undef PG8_BAR
#undef PG8_SCHED
#undef PG8_AOFF
}
}

#define XB_TMO      128
#define XB_XCNT(j)  (256  + 64 * (j))
#define XB_XSUB(j)  (1280 + 64 * (j))
#define XB_XGEN(j)  (2304 + 64 * (j))
#define XB_TOP      3328
#define XB_TOPGEN   3392
#define XCD_BAR_WORDS 3456
#define XB_SPIN_CAP (1u << 18)
__device__ __forceinline__ unsigned xb_ld(unsigned* p)              { return __hip_atomic_load(p, __ATOMIC_RELAXED, __HIP_MEMORY_SCOPE_AGENT); }
__device__ __forceinline__ unsigned xb_add(unsigned* p, unsigned v) { return __hip_atomic_fetch_add(p, v, __ATOMIC_RELAXED, __HIP_MEMORY_SCOPE_AGENT); }
__device__ __forceinline__ unsigned xb_xcc_id() { return (unsigned)__builtin_amdgcn_s_getreg((3 << 11) | 20) & 0xFu; }
#define XB_SPIN(cond, bar) do { unsigned _sp = 0; while (cond) { __builtin_amdgcn_s_sleep(1); \
    if ((++_sp & 255u) == 0u) { if (xb_ld(&(bar)[XB_TMO])) break; if (_sp > XB_SPIN_CAP) { atomicAdd(&(bar)[XB_TMO], 1u); break; } } } } while (0)
struct XcdBarrier { unsigned* bar; unsigned x; volatile LAS unsigned* st; };
__device__ __forceinline__ XcdBarrier xcd_barrier_post(unsigned* bar, volatile LAS unsigned* st) {
    XcdBarrier b; b.bar = bar; b.x = xb_xcc_id(); b.st = st;
    if (threadIdx.x == 0) (void)xb_add(&bar[XB_XCNT(b.x)], 1u);
    return b;
}
__device__ __forceinline__ void xcd_barrier_complete(unsigned* bar, unsigned x, unsigned& nloc, unsigned& nx) {
    const unsigned G = gridDim.x * gridDim.y * gridDim.z;
    unsigned sum, cnt, mine, sp = 0u;
    for (;;) {
        sum = 0u; cnt = 0u; mine = 0u;
#pragma unroll
        for (unsigned j = 0; j < 16; ++j) { const unsigned c = xb_ld(&bar[XB_XCNT(j)]); sum += c; cnt += (c > 0u) ? 1u : 0u; mine = (j == x) ? c : mine; }
        if (sum == G) break;
        __builtin_amdgcn_s_sleep(1);
        if ((++sp & 255u) == 0u) { if (xb_ld(&bar[XB_TMO])) break; if (sp > XB_SPIN_CAP) { atomicAdd(&bar[XB_TMO], 1u); break; } }
    }
    nloc = mine > 0u ? mine : 1u; nx = cnt > 0u ? cnt : 1u;
}
__device__ __forceinline__ void xcd_barrier(const XcdBarrier& b) {
    asm volatile("s_waitcnt vmcnt(0)" ::: "memory");
    __syncthreads();
    if (threadIdx.x == 0) {
        unsigned* bar = b.bar;
        __builtin_amdgcn_s_waitcnt(0);
        unsigned nloc = b.st[0], nx = b.st[1];
        if (nloc == 0u) { xcd_barrier_complete(bar, b.x, nloc, nx); b.st[0] = nloc; b.st[1] = nx; }
        const unsigned old = xb_add(&bar[XB_XSUB(b.x)], 1u);
        const unsigned gen = old / nloc;
        if (old + 1u == (gen + 1u) * nloc) {
            __builtin_amdgcn_fence(__ATOMIC_RELEASE, "agent");
            asm volatile("s_waitcnt vmcnt(0)" ::: "memory");
            const unsigned og = xb_add(&bar[XB_TOP], 1u);
            const unsigned tg = og / nx;
            if (og + 1u == (tg + 1u) * nx) xb_add(&bar[XB_TOPGEN], 1u);
            else XB_SPIN(xb_ld(&bar[XB_TOPGEN]) == tg, bar);
            __builtin_amdgcn_fence(__ATOMIC_ACQUIRE, "agent");
            xb_add(&bar[XB_XGEN(b.x)], 1u);
            asm volatile("s_waitcnt vmcnt(0)" ::: "memory");
        } else {
            XB_SPIN(xb_ld(&bar[XB_XGEN(b.x)]) == gen, bar);
            __builtin_amdgcn_fence(__ATOMIC_ACQUIRE, "agent");
            asm volatile("s_waitcnt vmcnt(0)" ::: "memory");
        }
    }
    __syncthreads();
}

struct Args {
    const float* x; const float* w_in; const float* b_in; const float* sinks; const float* rel; const float* wa; const float* wb; const float* wo;
    const float* g1; const float* b1; const float* wgr; const float* bgr; const float* wer; const float* ber; const float* wg; const float* wu; const float* wd;
    const float* g2; const float* b2; float* out; unsigned char* ws; int ph_lo, ph_hi, li, pad;
};

struct ProbInProj {
    static constexpr int PERM = 2; static constexpr bool FP8 = true; static constexpr int SCALE = 0x77777777;
    int KB; const char* A; const char* Bt; pg8::StaticOrder S; bf16_t* qkv; unsigned char* gates; const float* bias; float* kpart;
    __device__ __forceinline__ bool next(int i, pg8::Unit& u) const { return S.next(i, u); }
    __device__ __forceinline__ unsigned a_rowoff(const pg8::Unit& u, int row) const { return (unsigned)(u.pm * 256 + row) * (unsigned)DM; }
    __device__ __forceinline__ const char* b_ptr(const pg8::Unit& u) const { return Bt + (size_t)u.pn * 256 * DM; }
    __device__ __forceinline__ bool epi(f32x4 (&acc)[2][2][4][2], const pg8::Unit& u, int wr, int wc, int fr, int fq, LAS unsigned char* stg) const {
        const int pn = u.pn; const float sc = (pn == 0 || pn == 1 || pn == 3 || pn == 4) ? C2 : 1.0f;
        const int ct = wc * 64 + 16 * fq;
        f32x4 bv[2][2];
#pragma unroll
        for (int bj = 0; bj < 2; ++bj)
#pragma unroll
            for (int n = 0; n < 2; ++n) bv[bj][n] = *(const f32x4*)(bias + pn * 256 + ct + 8 * bj + 4 * n);
        if (pn == 5 || pn == 6) {
#pragma unroll
            for (int bj = 0; bj < 2; ++bj)
#pragma unroll
                for (int n = 0; n < 2; ++n) { f32x4 s = (f32x4){0.f, 0.f, 0.f, 0.f};
#pragma unroll
                    for (int ai = 0; ai < 2; ++ai)
#pragma unroll
                        for (int m = 0; m < 4; ++m) s += acc[ai][bj][m][n];
#pragma unroll
                    for (int e = 0; e < 4; ++e) s[e] = row16_sum(s[e]);
                    if (fr == 0) *(f32x4*)(kpart + ((size_t)u.pm * 2 + wr) * 512 + (pn - 5) * 256 + ct + 8 * bj + 4 * n) = s + bv[bj][n] * 128.0f; }
        }
#pragma unroll
        for (int ai = 0; ai < 2; ++ai)
#pragma unroll
            for (int m = 0; m < 4; ++m) { const size_t row = (size_t)(u.pm * 256 + ai * 128 + wr * 64 + m * 16 + fr);
                if (pn < 9) {
                    const int lane = fq * 16 + fr;
#pragma unroll
                    for (int bj = 0; bj < 2; ++bj) { const f32x4 v0 = (acc[ai][bj][m][0] + bv[bj][0]) * sc, v1 = (acc[ai][bj][m][1] + bv[bj][1]) * sc;
                        u32x4 w; w.x = cvt_pk_bf16(v0[0], v0[1]); w.y = cvt_pk_bf16(v0[2], v0[3]); w.z = cvt_pk_bf16(v1[0], v1[1]); w.w = cvt_pk_bf16(v1[2], v1[3]);
                        *(LAS u32x4*)(stg + fr * 144 + fq * 32 + bj * 16) = w; }
#pragma unroll
                    for (int hf = 0; hf < 2; ++hf) { const int rr = hf * 8 + (lane >> 3); const u32x4 w = *(const LAS u32x4*)(stg + rr * 144 + (lane & 7) * 16);
                        st_wt16(qkv + (size_t)(u.pm * 256 + ai * 128 + wr * 64 + m * 16 + rr) * NQKV + pn * 256 + wc * 64 + (lane & 7) * 8, w); } }
                else { unsigned char* rowp = gates + row * NGATE + (pn - 9) * 256 + ct;
                    u32x4 w;
#pragma unroll
                    for (int bj = 0; bj < 2; ++bj) { f32x4 v0 = (acc[ai][bj][m][0] + bv[bj][0]) * (-LOG2E), v1 = (acc[ai][bj][m][1] + bv[bj][1]) * (-LOG2E);
#pragma unroll
                        for (int e = 0; e < 4; ++e) { v0[e] = clampf(v0[e], -448.f, 448.f); v1[e] = clampf(v1[e], -448.f, 448.f); }
                        w[2 * bj] = pk4_fp8(v0[0], v0[1], v0[2], v0[3]); w[2 * bj + 1] = pk4_fp8(v1[0], v1[1], v1[2], v1[3]); }
                    *(u32x4*)rowp = w; } }
        return true;
    }
};

struct ProbBranch {
    static constexpr int PERM = 2; static constexpr bool FP8 = true; static constexpr int SCALE = 0x7B7B7B7B;
    int KB; const char* A; const char* WaT; const char* WbT; pg8::StaticOrder S; const unsigned char* gates; unsigned char* merged;
    __device__ __forceinline__ bool next(int i, pg8::Unit& u) const { const bool ok = S.next(i >> 1, u); u.aux = i & 1; return ok; }
    __device__ __forceinline__ unsigned a_rowoff(const pg8::Unit& u, int row) const { return (unsigned)(u.pm * 256 + row) * (unsigned)DM + (unsigned)u.aux * 512u; }
    __device__ __forceinline__ const char* b_ptr(const pg8::Unit& u) const { return (u.aux ? WbT : WaT) + (size_t)u.pn * 256 * 512; }
    __device__ __forceinline__ bool epi(f32x4 (&acc)[2][2][4][2], const pg8::Unit& u, int wr, int wc, int fr, int fq, LAS unsigned char* stg) const {
        const int ct = u.pn * 256 + wc * 64 + 16 * fq;
        if (u.aux == 0) {
#pragma unroll
            for (int ai = 0; ai < 2; ++ai)
#pragma unroll
                for (int m = 0; m < 4; ++m) { const unsigned char* gp = gates + (size_t)(u.pm * 256 + ai * 128 + wr * 64 + m * 16 + fr) * NGATE + ct;
                    const u32x4 ga = *(const u32x4*)gp, gb = *(const u32x4*)(gp + 1024);
#pragma unroll
                    for (int bj = 0; bj < 2; ++bj) {
                        const int gaw[2] = {(int)ga[2 * bj], (int)ga[2 * bj + 1]}, gbw[2] = {(int)gb[2 * bj], (int)gb[2 * bj + 1]};
#pragma unroll
                        for (int n = 0; n < 2; ++n)
#pragma unroll
                            for (int h = 0; h < 2; ++h) {
                                const f32x2 t1 = h ? __builtin_amdgcn_cvt_pk_f32_fp8(gaw[n], true) : __builtin_amdgcn_cvt_pk_f32_fp8(gaw[n], false);
                                const f32x2 t2 = h ? __builtin_amdgcn_cvt_pk_f32_fp8(gbw[n], true) : __builtin_amdgcn_cvt_pk_f32_fp8(gbw[n], false);
                                const f32x2 d1 = (f32x2){__builtin_amdgcn_exp2f(t1.x), __builtin_amdgcn_exp2f(t1.y)} + 1.0f;
                                const f32x2 d2 = (f32x2){__builtin_amdgcn_exp2f(t2.x), __builtin_amdgcn_exp2f(t2.y)} + 1.0f;
                                const f32x2 r = d2 * (f32x2){__builtin_amdgcn_rcpf(d1.x), __builtin_amdgcn_rcpf(d1.y)};
                                acc[ai][bj][m][n][2 * h] *= r.x; acc[ai][bj][m][n][2 * h + 1] *= r.y; } } }
            return false;
        }
#pragma unroll
        for (int ai = 0; ai < 2; ++ai)
#pragma unroll
            for (int m = 0; m < 4; ++m) { const size_t row = (size_t)(u.pm * 256 + ai * 128 + wr * 64 + m * 16 + fr); const unsigned char* gp = gates + row * NGATE + 1024 + ct; unsigned char* op = merged + row * DM + ct;
                const u32x4 gb = *(const u32x4*)gp; u32x4 w;
#pragma unroll
                for (int bj = 0; bj < 2; ++bj) { const int gbw[2] = {(int)gb[2 * bj], (int)gb[2 * bj + 1]}; float o[8];
#pragma unroll
                    for (int n = 0; n < 2; ++n)
#pragma unroll
                        for (int h = 0; h < 2; ++h) {
                            const f32x2 t2 = h ? __builtin_amdgcn_cvt_pk_f32_fp8(gbw[n], true) : __builtin_amdgcn_cvt_pk_f32_fp8(gbw[n], false);
                            const f32x2 d2 = (f32x2){__builtin_amdgcn_exp2f(t2.x), __builtin_amdgcn_exp2f(t2.y)} + 1.0f;
                            o[4 * n + 2 * h]     = clampf(acc[ai][bj][m][n][2 * h]     * __builtin_amdgcn_rcpf(d2.x), -448.f, 448.f);
                            o[4 * n + 2 * h + 1] = clampf(acc[ai][bj][m][n][2 * h + 1] * __builtin_amdgcn_rcpf(d2.y), -448.f, 448.f); }
                    w[2 * bj] = pk4_fp8(o[0], o[1], o[2], o[3]); w[2 * bj + 1] = pk4_fp8(o[4], o[5], o[6], o[7]); }
                *(u32x4*)op = w; }
        return true;
    }
};

struct ProbOut {
    static constexpr int PERM = 2; static constexpr bool FP8 = true; static constexpr int SCALE = 0x7A7A7A7A;
    int KB; const char* A; const char* Bt; pg8::StaticOrder S; unsigned char* h;
    __device__ __forceinline__ bool next(int i, pg8::Unit& u) const { return S.next(i, u); }
    __device__ __forceinline__ unsigned a_rowoff(const pg8::Unit& u, int row) const { return (unsigned)(u.pm * 256 + row) * (unsigned)DM; }
    __device__ __forceinline__ const char* b_ptr(const pg8::Unit& u) const { return Bt + (size_t)u.pn * 256 * DM; }
    __device__ __forceinline__ bool epi(f32x4 (&acc)[2][2][4][2], const pg8::Unit& u, int wr, int wc, int fr, int fq, LAS unsigned char* stg) const {
        const int ct = u.pn * 256 + wc * 64 + 16 * fq;
#pragma unroll
        for (int ai = 0; ai < 2; ++ai)
#pragma unroll
            for (int m = 0; m < 4; ++m) { const size_t off = (size_t)(u.pm * 256 + ai * 128 + wr * 64 + m * 16 + fr) * DM + ct; u32x4 w;
#pragma unroll
                for (int bj = 0; bj < 2; ++bj) { f32x4 v0 = acc[ai][bj][m][0], v1 = acc[ai][bj][m][1];
#pragma unroll
                    for (int e = 0; e < 4; ++e) { v0[e] = clampf(v0[e], -448.f, 448.f); v1[e] = clampf(v1[e], -448.f, 448.f); }
                    w[2 * bj] = pk4_fp8(v0[0], v0[1], v0[2], v0[3]); w[2 * bj + 1] = pk4_fp8(v1[0], v1[1], v1[2], v1[3]); }
                *(u32x4*)(h + off) = w; }
        return true;
    }
};

struct MoeTab { const LAS int* cnt; const LAS int* pre; const LAS unsigned char* te; int total_units; int G; int vcu; };
__device__ __forceinline__ bool moe_next(const MoeTab& T, int i, pg8::Unit& u) {
    const int L = i * T.G + T.vcu; if (L >= T.total_units) return false;
    const int rt = L >> 2; u.pn = L & 3;
    const int e = __builtin_amdgcn_readfirstlane((int)T.te[rt]); u.aux = e; u.pm = rt; u.aux2 = rt - __builtin_amdgcn_readfirstlane(T.pre[e]); return true;
}

struct ProbGateUp {
    static constexpr int PERM = 1; static constexpr bool FP8 = true; static constexpr int SCALE = 0x76767676;
    int KB; const char* A; const char* Bt; MoeTab T; const u32x2* list; unsigned char* act;
    __device__ __forceinline__ bool next(int i, pg8::Unit& u) const { return moe_next(T, i, u); }
    __device__ __forceinline__ unsigned a_rowoff(const pg8::Unit& u, int row) const {
        const int c = T.cnt[u.aux]; int r = u.aux2 * 256 + row; r = r < c ? r : c - 1;
        const unsigned aid = list[(size_t)u.aux * MTOK + r].x; return (aid >> 1) * (unsigned)DM;
    }
    __device__ __forceinline__ const char* b_ptr(const pg8::Unit& u) const { return Bt + ((size_t)u.aux * 4 + u.pn) * 256 * DM; }
    __device__ __forceinline__ bool epi(f32x4 (&acc)[2][2][4][2], const pg8::Unit& u, int wr, int wc, int fr, int fq, LAS unsigned char* stg) const {
        const int ct = u.pn * 128 + wc * 32 + 8 * fq; const int c = T.cnt[u.aux];
        float wrow[2][4];
#pragma unroll
        for (int ai = 0; ai < 2; ++ai)
#pragma unroll
            for (int m = 0; m < 4; ++m) { int r = u.aux2 * 256 + ai * 128 + wr * 64 + m * 16 + fr; r = r < c ? r : c - 1; wrow[ai][m] = __uint_as_float(list[(size_t)u.aux * MTOK + r].y) * 32.0f; }
#pragma unroll
        for (int ai = 0; ai < 2; ++ai)
#pragma unroll
            for (int m = 0; m < 4; ++m) { unsigned char* op = act + (size_t)(u.pm * 256 + ai * 128 + wr * 64 + m * 16 + fr) * DEXP + ct; float o[8]; const float w32 = wrow[ai][m];
#pragma unroll
                for (int n = 0; n < 2; ++n)
#pragma unroll
                    for (int h = 0; h < 2; ++h) {
                        const f32x2 g = {acc[ai][0][m][n][2 * h], acc[ai][0][m][n][2 * h + 1]}, up = {acc[ai][1][m][n][2 * h], acc[ai][1][m][n][2 * h + 1]};
                        const f32x2 t = g * (-LOG2E);
                        const f32x2 d = (f32x2){__builtin_amdgcn_exp2f(t.x), __builtin_amdgcn_exp2f(t.y)} + 1.0f;
                        const f32x2 r = g * (f32x2){__builtin_amdgcn_rcpf(d.x), __builtin_amdgcn_rcpf(d.y)} * (up * w32);
                        o[4 * n + 2 * h] = clampf(r.x, -448.f, 448.f); o[4 * n + 2 * h + 1] = clampf(r.y, -448.f, 448.f); }
                u32x2 w; w.x = pk4_fp8(o[0], o[1], o[2], o[3]); w.y = pk4_fp8(o[4], o[5], o[6], o[7]);
                *(u32x2*)op = w; }
        return true;
    }
};

struct ProbDown {
    static constexpr int PERM = 2; static constexpr bool FP8 = true; static constexpr int SCALE = 0x7B7B7B7B;
    int KB; const char* A; const char* Bt; MoeTab T; const u32x2* list; unsigned char* ys;
    __device__ __forceinline__ bool next(int i, pg8::Unit& u) const { return moe_next(T, i, u); }
    __device__ __forceinline__ unsigned a_rowoff(const pg8::Unit& u, int row) const { return (unsigned)(u.pm * 256 + row) * (unsigned)DEXP; }
    __device__ __forceinline__ const char* b_ptr(const pg8::Unit& u) const { return Bt + ((size_t)u.aux * 4 + u.pn) * 256 * DEXP; }
    __device__ __forceinline__ bool epi(f32x4 (&acc)[2][2][4][2], const pg8::Unit& u, int wr, int wc, int fr, int fq, LAS unsigned char* stg) const {
        const int ct = u.pn * 256 + wc * 64 + 16 * fq; const int c = T.cnt[u.aux];
        unsigned aidr[2][4];
#pragma unroll
        for (int ai = 0; ai < 2; ++ai)
#pragma unroll
            for (int m = 0; m < 4; ++m) { int r = u.aux2 * 256 + ai * 128 + wr * 64 + m * 16 + fr; r = r < c ? r : c - 1; aidr[ai][m] = list[(size_t)u.aux * MTOK + r].x; }
#pragma unroll
        for (int ai = 0; ai < 2; ++ai)
#pragma unroll
            for (int m = 0; m < 4; ++m) { const int r = u.aux2 * 256 + ai * 128 + wr * 64 + m * 16 + fr;
                if (r < c) { unsigned char* op = ys + (size_t)aidr[ai][m] * DM + ct; u32x4 w;
#pragma unroll
                    for (int bj = 0; bj < 2; ++bj) { f32x4 v0 = acc[ai][bj][m][0], v1 = acc[ai][bj][m][1];
#pragma unroll
                        for (int e = 0; e < 4; ++e) { v0[e] = clampf(v0[e], -448.f, 448.f); v1[e] = clampf(v1[e], -448.f, 448.f); }
                        w[2 * bj] = pk4_fp8(v0[0], v0[1], v0[2], v0[3]); w[2 * bj + 1] = pk4_fp8(v1[0], v1[1], v1[2], v1[3]); }
                    *(u32x4*)op = w; } }
        return true;
    }
};

__device__ __forceinline__ void p0_transpose_item(const float* W, int N, int k0, int n0, bf16_t* dst0, int ldt, LAS float* scr, int lane) {
#pragma unroll 8
    for (int i = 0; i < 32; ++i) { const int kk = 2 * i + (lane >> 5); scr[kk * 33 + (lane & 31)] = W[(size_t)(k0 + kk) * N + n0 + (lane & 31)]; }
    asm volatile("s_waitcnt lgkmcnt(0)" ::: "memory");
    const int c = lane & 7;
#pragma unroll
    for (int j = 0; j < 4; ++j) { const int n = (lane >> 3) + 8 * j; const LAS float* s = scr + (8 * c) * 33 + n;
        u32x4 o; o.x = cvt_pk_bf16(s[0 * 33], s[1 * 33]); o.y = cvt_pk_bf16(s[2 * 33], s[3 * 33]); o.z = cvt_pk_bf16(s[4 * 33], s[5 * 33]); o.w = cvt_pk_bf16(s[6 * 33], s[7 * 33]);
        *(u32x4*)(dst0 + (size_t)n * ldt + 8 * c) = o; }
    asm volatile("s_waitcnt lgkmcnt(0)" ::: "memory");
}

__device__ __forceinline__ void p0_transpose_item_fp8(const float* W, int N, int k0, int n0, unsigned char* dst0, int ldt, LAS float* scr, int lane, float sc) {
#pragma unroll 8
    for (int i = 0; i < 32; ++i) { const int kk = 2 * i + (lane >> 5); scr[kk * 33 + (lane & 31)] = ldnt(W + (size_t)(k0 + kk) * N + n0 + (lane & 31)); }
    asm volatile("s_waitcnt lgkmcnt(0)" ::: "memory");
    const int n = lane >> 1;
#pragma unroll
    for (int j = 0; j < 2; ++j) { const int c = 2 * (lane & 1) + j; const LAS float* s = scr + (16 * c) * 33 + n; float v[16];
#pragma unroll
        for (int i = 0; i < 16; ++i) v[i] = clampf(s[i * 33] * sc, -448.f, 448.f);
        u32x4 o; o.x = pk4_fp8(v[0], v[1], v[2], v[3]); o.y = pk4_fp8(v[4], v[5], v[6], v[7]); o.z = pk4_fp8(v[8], v[9], v[10], v[11]); o.w = pk4_fp8(v[12], v[13], v[14], v[15]);
        *(u32x4*)(dst0 + (size_t)n * ldt + 16 * c) = o; }
    asm volatile("s_waitcnt lgkmcnt(0)" ::: "memory");
}

__device__ __forceinline__ int rel_bucket(int n) {
    if (n < 16) return n;
    int b = 16;
    b += (n >= 19) + (n >= 21) + (n >= 24) + (n >= 27) + (n >= 31) + (n >= 35) + (n >= 40) + (n >= 46) + (n >= 52) + (n >= 59) + (n >= 67) + (n >= 77) + (n >= 87) + (n >= 99) + (n >= 113);
    return b;
}


__device__ __forceinline__ void load_q64(const bf16_t* qp, float (&qf)[64]) {
#pragma unroll
    for (int c = 0; c < 8; ++c) { const u32x4 w = *(const u32x4*)(qp + 8 * c);
        qf[8 * c + 0] = bf_lo(w.x); qf[8 * c + 1] = bf_hi(w.x); qf[8 * c + 2] = bf_lo(w.y); qf[8 * c + 3] = bf_hi(w.y);
        qf[8 * c + 4] = bf_lo(w.z); qf[8 * c + 5] = bf_hi(w.z); qf[8 * c + 6] = bf_lo(w.w); qf[8 * c + 7] = bf_hi(w.w); }
}
__device__ __forceinline__ float dot64(const bf16_t* kp, const float (&qf)[64]) {
    float s0 = 0.f, s1 = 0.f;
#pragma unroll
    for (int c = 0; c < 8; ++c) { const u32x4 w = *(const u32x4*)(kp + 8 * c);
        s0 += qf[8 * c + 0] * bf_lo(w.x); s1 += qf[8 * c + 1] * bf_hi(w.x); s0 += qf[8 * c + 2] * bf_lo(w.y); s1 += qf[8 * c + 3] * bf_hi(w.y);
        s0 += qf[8 * c + 4] * bf_lo(w.z); s1 += qf[8 * c + 5] * bf_hi(w.z); s0 += qf[8 * c + 6] * bf_lo(w.w); s1 += qf[8 * c + 7] * bf_hi(w.w); }
    return s0 + s1;
}

namespace att {
using s16x4=__attribute__((ext_vector_type(4)))short;
using f32x16=__attribute__((ext_vector_type(16)))float;
constexpr int D=64,NW=8,QBLK=32,QB=256,KVBLK=64;
constexpr int QP=NQKV, OP=DM;
constexpr float OSC=64.f;
constexpr float BIG=30000.f;
__device__ __forceinline__ int crow(int r,int hi){return (r&3)+8*(r>>2)+4*hi;}
#define SBAR() __builtin_amdgcn_sched_barrier(0)
constexpr int NSLOT=3, SLOTB=8192;
constexpr int LDS_K=0, LDS_V=NSLOT*SLOTB, LDS_WS=2*NSLOT*SLOTB, LDS_OST=LDS_WS+NW*64*4, LDS_BYTES=LDS_OST+NW*4096, LDS_KM=90112, LDS_TS=94208, LDS_TM=104448;
__device__ __forceinline__ void glds16(const void*sbase,unsigned voff,unsigned lds_dst){unsigned keep;
  asm volatile("s_mov_b32 %0, m0\n\ts_mov_b32 m0, %2\n\ts_nop 2\n\tglobal_load_lds_dwordx4 %1, %3\n\ts_mov_b32 m0, %0":"=&s"(keep):"v"(voff),"s"(lds_dst),"s"(sbase):"memory");}
__device__ __forceinline__ float max3f(float a,float b,float c){float r;asm("v_max3_f32 %0, %1, %2, %3":"=v"(r):"v"(a),"v"(b),"v"(c));return r;}
__device__ __forceinline__ float max2f(float a,float b){float r;asm("v_max_f32_e32 %0, %1, %2":"=v"(r):"v"(a),"v"(b));return r;}
__device__ __forceinline__ float fadd_s(float a,float b){float r;asm("v_add_f32_e32 %0, %1, %2":"=v"(r):"v"(a),"v"(b));return r;}
__device__ __forceinline__ float fsub_s(float a,float b){float r;asm("v_sub_f32_e32 %0, %1, %2":"=v"(r):"v"(a),"v"(b));return r;}
typedef float f32x2_t __attribute__((ext_vector_type(2))); typedef __bf16 bf16x2_t __attribute__((ext_vector_type(2)));
__device__ __forceinline__ unsigned cvtpk_s(float lo,float hi){f32x2_t v={lo,hi};bf16x2_t b=__builtin_convertvector(v,bf16x2_t);return __builtin_bit_cast(unsigned,b);}
#define WAIT_BAR(N) asm volatile("s_waitcnt vmcnt(" #N ") lgkmcnt(0)\n\ts_barrier":::"memory")

__device__ __forceinline__ void qkt(f32x16&p0,f32x16&p1,const char*Kslot,const bf16x8*qr,const bf16x8 kones,const bf16x8 qaug,int r32,int hi){ const f32x16 negm=__builtin_amdgcn_mfma_f32_32x32x16_bf16(kones,qaug,f32x16{},0,0,0);
  const char*kb=Kslot+hi*1024+r32*16;
  #pragma unroll
  for(int d0=0;d0<4;++d0){
    const bf16x8 b0=*reinterpret_cast<const bf16x8*>(kb+d0*2048);
    const bf16x8 b1=*reinterpret_cast<const bf16x8*>(kb+d0*2048+512);
    if(d0==0){p0=__builtin_amdgcn_mfma_f32_32x32x16_bf16(b0,qr[0],negm,0,0,0);p1=__builtin_amdgcn_mfma_f32_32x32x16_bf16(b1,qr[0],negm,0,0,0);}
    else{p0=__builtin_amdgcn_mfma_f32_32x32x16_bf16(b0,qr[d0],p0,0,0,0);p1=__builtin_amdgcn_mfma_f32_32x32x16_bf16(b1,qr[d0],p1,0,0,0);}}
}
typedef __attribute__((address_space(3))) const char* lds_cptr;
typedef short v4i16_t __attribute__((ext_vector_type(4)));
__device__ __forceinline__ void kload8(bf16x8*kf,lds_cptr kp){
  kf[0]=*(const __attribute__((address_space(3))) bf16x8*)(kp);      kf[1]=*(const __attribute__((address_space(3))) bf16x8*)(kp+512);
  kf[2]=*(const __attribute__((address_space(3))) bf16x8*)(kp+2048); kf[3]=*(const __attribute__((address_space(3))) bf16x8*)(kp+2560);
  kf[4]=*(const __attribute__((address_space(3))) bf16x8*)(kp+4096); kf[5]=*(const __attribute__((address_space(3))) bf16x8*)(kp+4608);
  kf[6]=*(const __attribute__((address_space(3))) bf16x8*)(kp+6144); kf[7]=*(const __attribute__((address_space(3))) bf16x8*)(kp+6656);
}
__device__ __forceinline__ void kload2(bf16x8*kf,lds_cptr kp,int j){ kf[2*j]=*(const __attribute__((address_space(3))) bf16x8*)(kp+j*2048); kf[2*j+1]=*(const __attribute__((address_space(3))) bf16x8*)(kp+j*2048+512); }
__device__ __forceinline__ s16x4 vtr(lds_cptr p){ return __builtin_bit_cast(s16x4,__builtin_amdgcn_ds_read_tr16_b64_v4i16((__attribute__((address_space(3))) v4i16_t*)p)); }
__device__ __forceinline__ float rowmax(const f32x16&p0,const f32x16&p1){
  float a=max3f(p0[0],p0[1],p1[0]),b=max3f(p0[2],p0[3],p1[1]);a=max3f(a,p1[2],p1[3]);
  #pragma unroll
  for(int r=4;r<16;r+=4){a=max3f(a,p0[r],p0[r+1]);b=max3f(b,p0[r+2],p0[r+3]);a=max3f(a,p1[r],p1[r+1]);b=max3f(b,p1[r+2],p1[r+3]);}
  const float m=max2f(a,b);
  auto rr=__builtin_amdgcn_permlane32_swap(__float_as_uint(m),__float_as_uint(m),false,false);
  return max2f(__uint_as_float(rr[0]),__uint_as_float(rr[1]));
}
__device__ __forceinline__ void pv(f32x16*o,int vb,bf16x8 pa0,bf16x8 pa1,bf16x8 pa2,bf16x8 pa3){
  #pragma unroll
  for(int d0=0;d0<2;++d0){s16x4 lo[4],hi[4];
    #pragma unroll
    for(int ks=0;ks<4;++ks){
      asm volatile("ds_read_b64_tr_b16 %0,%1 offset:%c2":"=&v"(lo[ks]):"v"(vb),"i"(d0*4096+ks*1024):"memory");
      asm volatile("ds_read_b64_tr_b16 %0,%1 offset:%c2":"=&v"(hi[ks]):"v"(vb),"i"(d0*4096+ks*1024+512):"memory");}
    asm volatile("s_waitcnt lgkmcnt(0)":::"memory");SBAR();
    #define PK(k) (bf16x8){lo[k][0],lo[k][1],lo[k][2],lo[k][3],hi[k][0],hi[k][1],hi[k][2],hi[k][3]}
    o[d0]=__builtin_amdgcn_mfma_f32_32x32x16_bf16(pa0,PK(0),o[d0],0,0,0);
    o[d0]=__builtin_amdgcn_mfma_f32_32x32x16_bf16(pa1,PK(1),o[d0],0,0,0);
    o[d0]=__builtin_amdgcn_mfma_f32_32x32x16_bf16(pa2,PK(2),o[d0],0,0,0);
    o[d0]=__builtin_amdgcn_mfma_f32_32x32x16_bf16(pa3,PK(3),o[d0],0,0,0);
    #undef PK
  }
}

__device__ __forceinline__ void bandmask(f32x16&p0,f32x16&p1,const LAS float*tp){
  #pragma unroll
  for(int r=0;r<16;++r){ const int c=(r&3)+8*(r>>2); p0[r]+=tp[59-c]; p1[r]+=tp[27-c];
    if((r&3)==3){ asm volatile("":"+v"(p0),"+v"(p1)::"memory"); } }
}
#define ATTN_STORE16(p,v) st_wt16((p),(v))
template<class T> __device__ __forceinline__ T* uptr(T*p){ const unsigned long long v=(unsigned long long)p;
  return (T*)(((unsigned long long)(unsigned)__builtin_amdgcn_readfirstlane((int)(v>>32))<<32)|(unsigned long long)(unsigned)__builtin_amdgcn_readfirstlane((int)(unsigned)v)); }
template<int MODE,int THRL> __device__ __forceinline__ void attn_unit(const bf16_t*Qw0,const bf16_t*Kh_,const bf16_t*Vh_,unsigned char*Ow0,const int NT,const int q0rel,const LAS float*tab_,const LAS float*kml,const float*sinkp,const int tmin,char*shm,
    bf16x8 (&qr)[4],const bool first,const bool has_next,const bf16_t*Qn0,const bf16_t*Kn_,const bf16_t*Vn_,const int tminn,int&slot0){
  const bf16_t*const Kh=uptr(Kh_); const bf16_t*const Vh=uptr(Vh_); const bf16_t*const Kn=uptr(Kn_); const bf16_t*const Vn=uptr(Vn_);
  int tid_=threadIdx.x; asm volatile("":"+v"(tid_));
  const int tid=tid_,lane=tid&63,r32=lane&31,hi=lane>>5; const int wid=__builtin_amdgcn_readfirstlane(tid>>6);
  const bf16_t*Qw=(MODE==0)?Qw0+(long)((wid&1)*QBLK)*QP+(wid>>1)*D:Qw0+(long)(wid*QBLK)*QP;
  const LAS float*tab=(MODE==0)?tab_+(wid>>1)*320:tab_;
  const unsigned lds0=(unsigned)(uintptr_t)shm;
  float*wsf=(float*)(shm+LDS_WS)+wid*64;
  const int s0=(MODE==0)?0:slot0, s1=(s0==(NSLOT-1)*SLOTB)?0:s0+SLOTB, s2=(s1==(NSLOT-1)*SLOTB)?0:s1+SLOTB;
  const unsigned koff=(unsigned)(lane*QP+wid*8)*2u;
  const unsigned voffs=(unsigned)((16*(wid&3)+(lane>>2))*QP+(wid>>2)*32+(lane&3)*8)*2u;
  const unsigned kdst=lds0+LDS_K+wid*1024, vdst=lds0+LDS_V+wid*1024;
  #define TCL(t) ((MODE==0)?__builtin_amdgcn_readfirstlane((t)<tmin?tmin:(t)):(t))
  #define DMA_K(t,slot) glds16(Kh+(long)TCL(t)*KVBLK*QP,koff,(unsigned)__builtin_amdgcn_readfirstlane(kdst+(slot)))
  #define DMA_V(t,slot) glds16(Vh+(long)TCL(t)*KVBLK*QP,voffs,(unsigned)__builtin_amdgcn_readfirstlane(vdst+(slot)))
  const int vb0=(int)(lds0+LDS_V)+((lane>>4)&1)*32+(lane&3)*8+(4*hi+((lane&15)>>2))*64;
  const char*Kbase=shm+LDS_K+s0; bf16x8 kf[8];
  const lds_cptr shm3=(lds_cptr)shm; const lds_cptr kp0=shm3+LDS_K+hi*1024+r32*16; const lds_cptr vp0=shm3+LDS_V+((lane>>4)&1)*32+(lane&3)*8+(4*hi+((lane&15)>>2))*64;
  #define TCLN(t) ((MODE==0)?__builtin_amdgcn_readfirstlane((t)<tminn?tminn:(t)):(t))
  #define DMA_KN(t,slot) glds16(Kn+(long)TCLN(t)*KVBLK*QP,koff,(unsigned)__builtin_amdgcn_readfirstlane(kdst+(slot)))
  #define DMA_VN(t,slot) glds16(Vn+(long)TCLN(t)*KVBLK*QP,voffs,(unsigned)__builtin_amdgcn_readfirstlane(vdst+(slot)))
  if(first){
  DMA_K(0,s0);DMA_V(0,s0);DMA_K(1,s1);
  #pragma unroll
  for(int d0=0;d0<4;++d0)qr[d0]=*reinterpret_cast<const bf16x8*>(&Qw[(long)r32*QP+d0*16+hi*8]);
  }
  unsigned selmask=0u; float b31=0.f;
  if(MODE==1){ const int qb=(NT>>2)-1; b31=__uint_as_float(__builtin_amdgcn_readfirstlane(__float_as_uint(tab[256+127])));
    if(qb<=3) selmask=(1u<<qb)-1u;
    else{ float qv[32];
      #pragma unroll
      for(int d0=0;d0<4;++d0)
        #pragma unroll
        for(int e=0;e<8;++e)qv[d0*8+e]=__uint_as_float(((unsigned)(unsigned short)qr[d0][e])<<16);
      float v1=-INFINITY,v2=-INFINITY,v3=-INFINITY; int i1=0,i2=0,i3=0;
      for(int j=0;j<qb;++j){ const LAS float*km=kml+j*64+8*hi; float g=0.f;
        #pragma unroll
        for(int d0=0;d0<4;++d0){ const f32x4 ka=*(const LAS f32x4*)(km+16*d0), kb=*(const LAS f32x4*)(km+16*d0+4);
          g+=qv[d0*8+0]*ka[0]+qv[d0*8+1]*ka[1]+qv[d0*8+2]*ka[2]+qv[d0*8+3]*ka[3]+qv[d0*8+4]*kb[0]+qv[d0*8+5]*kb[1]+qv[d0*8+6]*kb[2]+qv[d0*8+7]*kb[3]; }
        { auto rr_=__builtin_amdgcn_permlane32_swap(__float_as_uint(g),__float_as_uint(g),false,false); g=__uint_as_float(rr_[0])+__uint_as_float(rr_[1]); }
        if(g>v1){v3=v2;i3=i2;v2=v1;i2=i1;v1=g;i1=j;} else if(g>v2){v3=v2;i3=i2;v2=g;i2=j;} else if(g>v3){v3=g;i3=j;} }
      selmask=(1u<<i1)|(1u<<i2)|(1u<<i3); } }
  #define ADDT(t) ((MODE==0)?(((t)<tmin)?-BIG:0.f):(((t)>=NT-4)?0.f:(((selmask>>((t)>>2))&1u)?(((t)<NT-6)?b31:0.f):-BIG)))
  float mhat=0.f,l_reg=0.f;f32x16 o[2];o[0]=f32x16{};o[1]=f32x16{};const f32x16 Z16=f32x16{};
  bf16x8 kones=bf16x8{}; { const short one_=(hi==0)?(short)0x3F80:(short)0; kones[0]=one_; kones[1]=one_; } asm volatile("":"+v"(kones));
  bf16x8 qaug=bf16x8{};
  #define SETAUG(t) do{ const float nm_=ADDT(t)-mhat; const unsigned h_=cvtpk_s(nm_,0.f)&0xffffu; const float l_=nm_-__uint_as_float(h_<<16); \
      const unsigned w_=(hi==0)?(h_|(cvtpk_s(l_,0.f)<<16)):0u; qaug[0]=(short)(w_&0xffffu); qaug[1]=(short)(w_>>16); }while(0)
  const int qpos=q0rel+((MODE==0)?(wid&1)*QBLK:wid*QBLK)+r32;
  const LAS float*const tpb=tab+((MODE==0)?64:256)+qpos-4*hi-59;
  #define CMASK(P0,P1,t) do{ if(MODE==0||(t)>=NT-6){ bandmask(P0,P1,tpb-64*(t)); } }while(0)
  bool resc=false;
  #define START(P0,P1) do{ const float rm=rowmax(P0,P1); resc=false; \
    { const float dl=__builtin_fmaxf(rm,0.f); mhat=dl; \
      _Pragma("unroll") for(int r=0;r<16;++r){P0[r]=fsub_s(P0[r],dl);P1[r]=fsub_s(P1[r],dl);} } \
    _Pragma("unroll") for(int r=0;r<16;++r)P0[r]=__builtin_amdgcn_exp2f(P0[r]); }while(0)
  #define RESC() do{ if(__builtin_expect(resc,0)){ asm volatile("s_waitcnt lgkmcnt(0)":::"memory"); \
      _Pragma("unroll") for(int d_=0;d_<2;++d_) _Pragma("unroll") for(int r=0;r<16;++r)o[d_][r]*=wsf[crow(r,hi)]; } }while(0)
  f32x16 pA0,pA1,pB0,pB1;
  int sl_prev=s0,sl_cur=s0,sl_next=s1;
  #define ROT() do{sl_prev=sl_cur;sl_cur=sl_next;sl_next=(sl_next==(NSLOT-1)*SLOTB)?0:sl_next+SLOTB;}while(0)
  if(first){DMA_K(2,s2);}
  WAIT_BAR(3);
  SETAUG(0); qkt(pA0,pA1,Kbase,qr,kones,qaug,r32,hi);asm volatile("s_nop 15\n\ts_nop 7":"+v"(pA0),"+v"(pA1));CMASK(pA0,pA1,0);
  asm volatile("s_nop 7":"+v"(pA0),"+v"(pA1));
  START(pA0,pA1);
  _Pragma("unroll") for(int r=0;r<16;++r)pA1[r]=__builtin_amdgcn_exp2f(pA1[r]);
  WAIT_BAR(0);
  if(MODE==1){DMA_K(3,s0);} DMA_V(1,s1);
  ROT();
  kload8(kf,kp0+sl_cur);
  WAIT_BAR(2);
  s16x4 vlo[8],vhi[8]; u32x4 pw0,pw1,pw2,pw3;
  #define PKW(P,B) cvtpk_s(P[B],P[B+1])
  #define PAF(k) __builtin_bit_cast(bf16x8,pw##k)
  #define VFR(i) (bf16x8){vlo[i][0],vlo[i][1],vlo[i][2],vlo[i][3],vhi[i][0],vhi[i][1],vhi[i][2],vhi[i][3]}
  #define PIN(x) asm volatile("":"+v"(x))
  #define MX3(a,b,c) __builtin_fmaxf(__builtin_fmaxf((a),(b)),(c))
  #define GAPA(MF,A0,A1,A2,A3,W0,W1,PW) do{ MF; sacc+=(f32x2_t){A0,A1}; sacc+=(f32x2_t){A2,A3}; PIN(sacc); W0; W1; PIN(PW); SBAR(); }while(0)
  #define EX(v) __builtin_amdgcn_exp2f(v)
  #define GAPB(MF,X,B) do{ MF; X[B]=EX(X[B]); X[B+1]=EX(X[B+1]); X[B+2]=EX(X[B+2]); X[B+3]=EX(X[B+3]); PIN(X); SBAR(); }while(0)
  #define VRD(i) do{ vlo[i]=vtr(vp_+(((i)>>2)*4096+((i)&3)*1024)); vhi[i]=vtr(vp_+(((i)>>2)*4096+((i)&3)*1024+512)); }while(0)
  #define KRD(G,j) do{ if(G){ kload2(kf,kp0+sl_next,j); SBAR(); } }while(0)
  #define STEP(C0,C1,P0,P1,t,GK,GV,GL,DOMASK,PF) do{ SETAUG(t); SBAR(); \
    C0=__builtin_amdgcn_mfma_f32_32x32x16_bf16(kones,qaug,Z16,0,0,0); C1=__builtin_amdgcn_mfma_f32_32x32x16_bf16(kones,qaug,Z16,0,0,0); SBAR(); \
    const lds_cptr vp_=vp0+sl_prev; \
    VRD(0); SBAR(); f32x2_t sacc=(f32x2_t){P0[0],P0[1]}; \
    GAPA(C0=__builtin_amdgcn_mfma_f32_32x32x16_bf16(kf[0],qr[0],C0,0,0,0), P0[2],P0[3],P0[4],P0[5],     pw0[0]=PKW(P0,0), pw0[1]=PKW(P0,2), pw0); \
    VRD(4); SBAR(); GAPA(C1=__builtin_amdgcn_mfma_f32_32x32x16_bf16(kf[1],qr[0],C1,0,0,0), P0[6],P0[7],P0[8],P0[9],     pw0[2]=PKW(P0,4), pw0[3]=PKW(P0,6), pw0); \
    VRD(1); SBAR(); GAPA(C0=__builtin_amdgcn_mfma_f32_32x32x16_bf16(kf[2],qr[1],C0,0,0,0),   P0[10],P0[11],P0[12],P0[13], pw1[0]=PKW(P0,8), pw1[1]=PKW(P0,10), pw1); \
    VRD(5); SBAR(); GAPA(C1=__builtin_amdgcn_mfma_f32_32x32x16_bf16(kf[3],qr[1],C1,0,0,0),   P0[14],P0[15],P1[0],P1[1],   pw1[2]=PKW(P0,12),pw1[3]=PKW(P0,14), pw1); \
    VRD(2); SBAR(); GAPA(C0=__builtin_amdgcn_mfma_f32_32x32x16_bf16(kf[4],qr[2],C0,0,0,0),   P1[2],P1[3],P1[4],P1[5],     pw2[0]=PKW(P1,0), pw2[1]=PKW(P1,2), pw2); \
    VRD(6); SBAR(); GAPA(C1=__builtin_amdgcn_mfma_f32_32x32x16_bf16(kf[5],qr[2],C1,0,0,0),   P1[6],P1[7],P1[8],P1[9],     pw2[2]=PKW(P1,4), pw2[3]=PKW(P1,6), pw2); \
    VRD(3); SBAR(); GAPA(C0=__builtin_amdgcn_mfma_f32_32x32x16_bf16(kf[6],qr[3],C0,0,0,0),   P1[10],P1[11],P1[12],P1[13], pw3[0]=PKW(P1,8), pw3[1]=PKW(P1,10), pw3); \
    VRD(7); SBAR(); GAPA(C1=__builtin_amdgcn_mfma_f32_32x32x16_bf16(kf[7],qr[3],C1,0,0,0),   P1[14],P1[15],0.f,0.f,       pw3[2]=PKW(P1,12),pw3[3]=PKW(P1,14), pw3); \
    l_reg+=sacc.x+sacc.y; \
    if(GK){DMA_K((t)+3,sl_cur);} if(GV){DMA_V((t)+1,sl_next);} PF \
    if(DOMASK){CMASK(C0,C1,t);} \
    { float a=MX3(C0[0],C0[1],C1[0]),b=MX3(C0[2],C0[3],C1[1]); a=MX3(a,C1[2],C1[3]); \
      _Pragma("unroll") for(int r=4;r<16;r+=4){a=MX3(a,C0[r],C0[r+1]);b=MX3(b,C0[r+2],C0[r+3]);a=MX3(a,C1[r],C1[r+1]);b=MX3(b,C1[r+2],C1[r+3]);} \
      float rm=__builtin_fmaxf(a,b); { auto rr=__builtin_amdgcn_permlane32_swap(__float_as_uint(rm),__float_as_uint(rm),false,false); rm=__builtin_fmaxf(__uint_as_float(rr[0]),__uint_as_float(rr[1])); } \
      resc=false; \
      if(__builtin_expect(__any(rm>(float)THRL),0)){ const float dl=__builtin_fmaxf(rm,0.f); mhat+=dl; \
        _Pragma("unroll") for(int r=0;r<16;++r){C0[r]-=dl;C1[r]-=dl;} \
        const float f=__builtin_amdgcn_exp2f(-dl); l_reg*=f; if(hi==0)wsf[r32]=f; resc=true; } } \
    SBAR(); \
    GAPB(o[0]=__builtin_amdgcn_mfma_f32_32x32x16_bf16(PAF(0),VFR(0),o[0],0,0,0), C0,0); \
    GAPB(o[1]=__builtin_amdgcn_mfma_f32_32x32x16_bf16(PAF(0),VFR(4),o[1],0,0,0), C0,4); \
    KRD(GL,0); GAPB(o[0]=__builtin_amdgcn_mfma_f32_32x32x16_bf16(PAF(1),VFR(1),o[0],0,0,0), C0,8); \
    KRD(GL,1); GAPB(o[1]=__builtin_amdgcn_mfma_f32_32x32x16_bf16(PAF(1),VFR(5),o[1],0,0,0), C0,12); \
    KRD(GL,2); GAPB(o[0]=__builtin_amdgcn_mfma_f32_32x32x16_bf16(PAF(2),VFR(2),o[0],0,0,0), C1,0); \
    KRD(GL,3); GAPB(o[1]=__builtin_amdgcn_mfma_f32_32x32x16_bf16(PAF(2),VFR(6),o[1],0,0,0), C1,4); \
    GAPB(o[0]=__builtin_amdgcn_mfma_f32_32x32x16_bf16(PAF(3),VFR(3),o[0],0,0,0), C1,8); \
    GAPB(o[1]=__builtin_amdgcn_mfma_f32_32x32x16_bf16(PAF(3),VFR(7),o[1],0,0,0), C1,12); \
    }while(0)
  #define DRAIN(X0,X1) do{ float sacc=X0[0]+X0[1]; _Pragma("unroll") for(int r=2;r<16;++r)sacc+=X0[r]; _Pragma("unroll") for(int r=0;r<16;++r)sacc+=X1[r]; l_reg+=sacc; \
    pw0=(u32x4){PKW(X0,0),PKW(X0,2),PKW(X0,4),PKW(X0,6)};pw1=(u32x4){PKW(X0,8),PKW(X0,10),PKW(X0,12),PKW(X0,14)};pw2=(u32x4){PKW(X1,0),PKW(X1,2),PKW(X1,4),PKW(X1,6)};pw3=(u32x4){PKW(X1,8),PKW(X1,10),PKW(X1,12),PKW(X1,14)}; \
    SBAR(); pv(o,vb0+sl_cur,PAF(0),PAF(1),PAF(2),PAF(3)); }while(0)
  #define NEXTPF() do{ if(has_next){ DMA_KN(0,sl_next);DMA_VN(0,sl_next);DMA_KN(1,sl_prev);DMA_KN(2,sl_cur); slot0=sl_next; \
      const bf16_t*Qnw=(MODE==0)?Qn0+(long)((wid&1)*QBLK)*QP+(wid>>1)*D:Qn0+(long)(wid*QBLK)*QP; \
      _Pragma("unroll") for(int d0=0;d0<4;++d0)qr[d0]=*reinterpret_cast<const bf16x8*>(&Qnw[(long)r32*QP+d0*16+hi*8]); } }while(0)
  if(MODE==0){
    STEP(pB0,pB1,pA0,pA1,1,false,true,true,true,);   WAIT_BAR(0); RESC(); ROT();
    STEP(pA0,pA1,pB0,pB1,2,false,false,false,true,NEXTPF();); RESC();
    DRAIN(pA0,pA1);
  } else {
  int t=1;
  for(;t+7<NT;t+=2){
    STEP(pB0,pB1,pA0,pA1,t,true,true,true,false,);     WAIT_BAR(2); RESC(); ROT();
    STEP(pA0,pA1,pB0,pB1,t+1,true,true,true,false,);   WAIT_BAR(2); RESC(); ROT();
  }
  #define ENDW(tt) do{ if((tt)+3<NT){WAIT_BAR(2);} else if((tt)+2<NT){WAIT_BAR(1);} else {WAIT_BAR(0);} }while(0)
  for(;t+1<NT;t+=2){
    STEP(pB0,pB1,pA0,pA1,t,(t+3<NT),(t+1<NT),(t+1<NT),true,);       ENDW(t);   RESC(); ROT();
    STEP(pA0,pA1,pB0,pB1,t+1,(t+4<NT),(t+2<NT),(t+2<NT),true,);     ENDW(t+1); RESC(); ROT();
  }
  STEP(pB0,pB1,pA0,pA1,NT-1,false,false,false,true,NEXTPF();); RESC();
  DRAIN(pB0,pB1);
  }
  #undef DRAIN
  #undef NEXTPF
  #undef DMA_KN
  #undef DMA_VN
  #undef TCLN
  #undef PKW
  #undef PAF
  #undef VFR
  #undef PIN
  #undef MX3
  #undef GAPA
  #undef GAPB
  #undef EX
  #undef VRD
  #undef KRD
  #undef STEP
  #undef ENDW
  {auto rr=__builtin_amdgcn_permlane32_swap(__float_as_uint(l_reg),__float_as_uint(l_reg),false,false);l_reg=__uint_as_float(rr[0])+__uint_as_float(rr[1]);}
  if(MODE==0)l_reg+=__builtin_amdgcn_exp2f(sinkp[wid>>1]*LOG2E-mhat);
  if(hi==0)wsf[32+r32]=l_reg;asm volatile("s_waitcnt lgkmcnt(0)":::"memory");
  float rli[16];
  #pragma unroll
  for(int r=0;r<16;++r)rli[r]=__builtin_amdgcn_rcpf(wsf[32+crow(r,hi)]);
  unsigned char*Ow=(MODE==0)?Ow0+(long)((wid&1)*QBLK)*OP+(wid>>1)*D:Ow0+(long)(wid*QBLK)*OP;
  { unsigned char*stg=(unsigned char*)(shm+LDS_OST)+wid*4096;
    #pragma unroll
    for(int r=0;r<16;++r){const int orow=crow(r,hi); const float sc_=rli[r]*OSC;
      #pragma unroll
      for(int d0=0;d0<2;++d0){ const float v_=__builtin_fminf(__builtin_fmaxf(o[d0][r]*sc_,-448.f),448.f); stg[orow*64+d0*32+r32]=(unsigned char)(__builtin_amdgcn_cvt_pk_fp8_f32(v_,0.f,0,false)&0xff); } }
    asm volatile("s_waitcnt lgkmcnt(0)":::"memory");
    #pragma unroll
    for(int i=0;i<2;++i){const int row=i*16+(lane>>2),ch=lane&3; const u32x4 v=*(const u32x4*)(stg+row*64+ch*16); ATTN_STORE16(Ow+(long)row*OP+ch*16,v);} }
  asm volatile("s_waitcnt lgkmcnt(0)\n\ts_barrier":::"memory");
  #undef DMA_K
  #undef DMA_V
  #undef TCL
  #undef CMASK
  #undef START
  #undef RESC
  #undef ROT
  #undef ADDT
  #undef SETAUG
}
#undef SBAR
#undef WAIT_BAR
}

__global__ void __launch_bounds__(512, 2) fwd_kernel(Args a) {
    extern __shared__ __attribute__((aligned(16))) unsigned char lds_raw[];
    LAS unsigned char* lds = (LAS unsigned char*)lds_raw;
    volatile LAS unsigned* MISC = (volatile LAS unsigned*)(lds + MISC_OFF);
    const int tid = threadIdx.x, lane = tid & 63, wave = __builtin_amdgcn_readfirstlane(tid >> 6);
    const int G = gridDim.x; const int bx = blockIdx.x; const int vcu = (G % 8 == 0) ? (bx % 8) * (G / 8) + bx / 8 : bx;
    unsigned char* ws = a.ws;
    unsigned* ctl = (unsigned*)(ws + WS_CTL);
    for (int u = tid; u < (LDS_BYTES - LDSCTL_OFF) / 4; u += 512) ((LAS unsigned*)(lds + LDSCTL_OFF))[u] = 0u;
    __syncthreads();
    XcdBarrier bar; bar.bar = ctl + CW_BAR; bar.x = 0; bar.st = nullptr;
    if (MK_N_LAUNCHES == 1) bar = xcd_barrier_post(ctl + CW_BAR, MISC + 8);
    const int lo = a.ph_lo, hi = a.ph_hi;
#define IN(k) (lo <= (k) && (k) < hi)
#define SEAM(k) do { if (IN(k) && IN((k) + 1)) xcd_barrier(bar); } while (0)

    unsigned char* const win_t = ws + WS_WIN_T; unsigned char* const wa_t = ws + WS_WA_T; unsigned char* const wb_t = ws + WS_WB_T;
    unsigned char* const wo_t = ws + WS_WO_T; bf16_t* const wr_t = (bf16_t*)(ws + WS_WR_T); unsigned char* const gu_t = ws + WS_GU_T; unsigned char* const wd_t = ws + WS_WD_T; unsigned char* const x1f8 = ws + WS_X1F8;
    u32x2* const list = (u32x2*)(ws + WS_LIST); float* const kmean = (float*)(ws + WS_KMEAN);
    unsigned char* const x8 = ws + WS_R1; unsigned char* const ybuf = ws + WS_R1; bf16_t* const x1 = (bf16_t*)(ws + WS_R1);
    bf16_t* const qkv = (bf16_t*)(ws + WS_R2); unsigned char* const merged = ws + WS_R2; unsigned char* const act = ws + WS_R2;
    unsigned char* const gates = ws + WS_R3; unsigned char* const hbuf = ws + WS_R3; unsigned char* const ys = ws + WS_R3;
    const int gw = vcu * 8 + wave, NGW = G * 8;

    if (IN(0)) {
        LAS float* scr = (LAS float*)(lds + wave * 16384);
        constexpr int I_IN = 8 * 136, I_WA = 4 * 32, I_WO = 8 * 32, I_E = 128;
        constexpr int NIT = I_IN + 2 * I_WA + I_WO + 3 * NEXP * I_E;
        for (int it = gw; it < NIT; it += NGW) {
            int r = it;
            if (r < I_IN) { const int kb = r / 136, nb = r % 136;
#pragma unroll 1
                for (int h = 0; h < 2; ++h) p0_transpose_item_fp8(a.w_in, NPROJ, 128 * kb + 64 * h, 32 * nb, win_t + (size_t)(32 * nb) * DM + 128 * kb + 64 * h, DM, scr, lane, 64.0f);
                continue; } r -= I_IN;
            if (r < I_WA) { const int kb = r / 32, nb = r % 32;
#pragma unroll 1
                for (int h = 0; h < 2; ++h) p0_transpose_item_fp8(a.wa, DM, 128 * kb + 64 * h, 32 * nb, wa_t + (size_t)(32 * nb) * 512 + 128 * kb + 64 * h, 512, scr, lane, 64.0f);
                continue; } r -= I_WA;
            if (r < I_WA) { const int kb = r / 32, nb = r % 32;
#pragma unroll 1
                for (int h = 0; h < 2; ++h) p0_transpose_item_fp8(a.wb, DM, 128 * kb + 64 * h, 32 * nb, wb_t + (size_t)(32 * nb) * 512 + 128 * kb + 64 * h, 512, scr, lane, 64.0f);
                continue; } r -= I_WA;
            if (r < I_WO) { const int kb = r / 32, nb = r % 32;
#pragma unroll 1
                for (int h = 0; h < 2; ++h) p0_transpose_item_fp8(a.wo, DM, 128 * kb + 64 * h, 32 * nb, wo_t + (size_t)(32 * nb) * DM + 128 * kb + 64 * h, DM, scr, lane, 128.0f);
                continue; } r -= I_WO;
            if (r < 2 * NEXP * I_E) {
                const int up = r >= NEXP * I_E; if (up) r -= NEXP * I_E;
                const int e = r / I_E, q = r % I_E, kb = q / 16, nb = q % 16, n0 = 32 * nb;
                const float* W = (up ? a.wu : a.wg) + (size_t)e * DM * DEXP;
                unsigned char* dst = gu_t + ((size_t)e * 1024 + (n0 >> 7) * 256 + up * 128 + (n0 & 127)) * DM + 128 * kb;
#pragma unroll 1
                for (int h = 0; h < 2; ++h) p0_transpose_item_fp8(W, DEXP, 128 * kb + 64 * h, n0, dst + 64 * h, DM, scr, lane, 128.0f);
                continue; }
            r -= 2 * NEXP * I_E;
            { const int e = r / I_E, q = r % I_E, kb = q / 32, nb = q % 32;
#pragma unroll 1
              for (int h = 0; h < 2; ++h) p0_transpose_item_fp8(a.wd + (size_t)e * DEXP * DM, DM, 128 * kb + 64 * h, 32 * nb, wd_t + ((size_t)e * DM + 32 * nb) * DEXP + 128 * kb + 64 * h, DEXP, scr, lane, 64.0f); }
        }
        { const size_t nth = (size_t)G * 512, t0 = (size_t)vcu * 512 + tid;
          for (size_t i = t0; i < (size_t)MTOK * DM / 16; i += nth) { f32x4 v[4];
#pragma unroll
              for (int j = 0; j < 4; ++j) { v[j] = ldnt((const f32x4*)(a.x + i * 16 + 4 * j)) * 4.0f;
#pragma unroll
                  for (int e = 0; e < 4; ++e) v[j][e] = clampf(v[j][e], -448.f, 448.f); }
              u32x4 w; w.x = pk4_fp8(v[0][0], v[0][1], v[0][2], v[0][3]); w.y = pk4_fp8(v[1][0], v[1][1], v[1][2], v[1][3]); w.z = pk4_fp8(v[2][0], v[2][1], v[2][2], v[2][3]); w.w = pk4_fp8(v[3][0], v[3][1], v[3][2], v[3][3]);
              st_wt16(x8 + i * 16, w); } }
        { const int nth = G * 512, t0 = vcu * 512 + tid;
          for (int i = t0; i < 48 * DM / 2; i += nth) { const int n = i / (DM / 2), k = (i % (DM / 2)) * 2; float v0 = 0.f, v1 = 0.f;
              if (n < 4) { v0 = a.wgr[k * 4 + n]; v1 = a.wgr[(k + 1) * 4 + n]; } else if (n < 36) { v0 = a.wer[k * 32 + n - 4]; v1 = a.wer[(k + 1) * 32 + n - 4]; }
              *(unsigned*)(wr_t + (size_t)n * DM + k) = cvt_pk_bf16(v0, v1); } }
    }
    SEAM(0);

    if (IN(1)) {
        ProbInProj P; P.KB = DM; P.A = (const char*)x8; P.Bt = (const char*)win_t; P.S.init(MTOK, NPROJ, G, bx); P.qkv = qkv; P.gates = gates; P.bias = a.b_in; P.kpart = kmean;
        pg8::gemm_phase<ProbInProj>(lds, P);
    }
    SEAM(1);


    if (IN(3)) {
        char* shm = (char*)lds_raw;
        LAS float* tabS = (LAS float*)(lds + att::LDS_TS);
        LAS float* tabM = (LAS float*)(lds + att::LDS_TM);
        LAS float* kml = (LAS float*)(lds + att::LDS_KM);
        for (int i = tid; i < 8 * 320; i += 512) { const int h = i / 320, d = i % 320 - 64; tabS[i] = (d >= 0 && d < 128) ? a.rel[rel_bucket(d) * 16 + h] * LOG2E : -att::BIG; }
        for (int i = tid; i < 8 * 768; i += 512) { const int h = i / 768, d = i % 768 - 256; tabM[i] = (d >= 0) ? a.rel[rel_bucket(d < 127 ? d : 127) * 16 + 8 + h] * LOG2E : -att::BIG; }
        __syncthreads();
#if PROBE_ATTN
        { bf16_t* const yref = (bf16_t*)(ws + WS_PROBE); LAS float* tabn = (LAS float*)lds;
          for (int i = tid; i < 16 * 128; i += 512) { const int h = i >> 7, d = i & 127; tabn[i] = a.rel[rel_bucket(d) * 16 + h] * LOG2E; }
          __syncthreads();
        for (int it = gw; it < MTOK * 8; it += NGW) {
            const int hh = it & 7, m = it >> 3, t = m & (SEQ - 1), b = m >> 12;
            {
                const int kvh = hh >> 2; float qf[64]; load_q64(qkv + (size_t)m * NQKV + QS_OFF + hh * 64, qf);
                float s[2];
#pragma unroll
                for (int c = 0; c < 2; ++c) { const int kv = t - 127 + 64 * c + lane; const bool valid = kv >= 0; const int kvc = valid ? kv : 0;
                    const float d = dot64(qkv + (size_t)(b * SEQ + kvc) * NQKV + KS_OFF + kvh * 64, qf);
                    s[c] = valid ? d + tabn[hh * 128 + (t - kvc)] : -1e30f; }
                const float sink2 = a.sinks[hh] * LOG2E;
                const float mx = fmaxf(wave_max(fmaxf(s[0], s[1])), sink2);
                float p[2]; p[0] = __builtin_amdgcn_exp2f(s[0] - mx); p[1] = __builtin_amdgcn_exp2f(s[1] - mx);
                const float l = wave_sum(p[0] + p[1]) + __builtin_amdgcn_exp2f(sink2 - mx);
                float o = 0.f;
#pragma unroll
                for (int c = 0; c < 2; ++c) { const int kv0 = t - 127 + 64 * c; const bf16_t* vp = qkv + (size_t)(b * SEQ + kv0) * NQKV + VS_OFF + kvh * 64 + lane;
                    for (int kk = 0; kk < 64; ++kk) { if (kv0 + kk >= 0) { const float pk = __uint_as_float(__builtin_amdgcn_readlane(__float_as_uint(p[c]), kk)); o += pk * bf1(vp[(ptrdiff_t)kk * NQKV]); } } }
                yref[(size_t)m * DM + hh * 64 + lane] = (bf16_t)(cvt_pk_bf16(o / l, 0.f) & 0xffffu);
            }
            {
                const int qb = t >> 8; float qf[64]; load_q64(qkv + (size_t)m * NQKV + QM_OFF + hh * 64, qf);
                const float ql = bf1(qkv[(size_t)m * NQKV + QM_OFF + hh * 64 + lane]);
                float g[15];
#pragma unroll
                for (int j = 0; j < 15; ++j) { g[j] = -INFINITY; if (j < qb) g[j] = wave_sum(ql * (kmean[(size_t)(b * 16 + j) * 1024 + hh * 64 + lane] + kmean[(size_t)(b * 16 + j) * 1024 + 512 + hh * 64 + lane]) * (1.0f / 256.0f)); }
                int blk[4]; blk[0] = qb; blk[1] = -1; blk[2] = -1; blk[3] = -1;
                { float best = -INFINITY;
#pragma unroll
                  for (int j = 0; j < 15; ++j) if (g[j] > best) { best = g[j]; blk[1] = j; }
                  best = -INFINITY;
#pragma unroll
                  for (int j = 0; j < 15; ++j) if (j != blk[1] && g[j] > best) { best = g[j]; blk[2] = j; }
                  best = -INFINITY;
#pragma unroll
                  for (int j = 0; j < 15; ++j) if (j != blk[1] && j != blk[2] && g[j] > best) { best = g[j]; blk[3] = j; } }
                float s[16]; float mx = -1e30f;
#pragma unroll
                for (int bi = 0; bi < 4; ++bi)
#pragma unroll
                    for (int c = 0; c < 4; ++c) { float sv = -1e30f;
                        if (blk[bi] >= 0) { const int kv = blk[bi] * 256 + 64 * c + lane; const int dist = t - kv;
                            const float d = dot64(qkv + (size_t)(b * SEQ + kv) * NQKV + KM_OFF + hh * 64, qf);
                            sv = dist >= 0 ? d + tabn[(8 + hh) * 128 + (dist < 127 ? dist : 127)] : -1e30f; }
                        s[bi * 4 + c] = sv; mx = fmaxf(mx, sv); }
                mx = wave_max(mx); float ls = 0.f;
#pragma unroll
                for (int i = 0; i < 16; ++i) { s[i] = __builtin_amdgcn_exp2f(s[i] - mx); ls += s[i]; }
                const float l = wave_sum(ls); float o = 0.f;
#pragma unroll
                for (int bi = 0; bi < 4; ++bi)
#pragma unroll
                    for (int c = 0; c < 4; ++c) { if (blk[bi] >= 0) { const int kv0 = blk[bi] * 256 + 64 * c; const bf16_t* vp = qkv + (size_t)(b * SEQ + kv0) * NQKV + VM_OFF + hh * 64 + lane;
                            for (int kk = 0; kk < 64; ++kk) { if (kv0 + kk <= t) { const float pk = __uint_as_float(__builtin_amdgcn_readlane(__float_as_uint(s[bi * 4 + c]), kk)); o += pk * bf1(vp[(size_t)kk * NQKV]); } } } }
                yref[(size_t)m * DM + 512 + hh * 64 + lane] = (bf16_t)(cvt_pk_bf16(o / l, 0.f) & 0xffffu);
            }
        }

        }
        __syncthreads();
#endif
        for (int vw = vcu; vw < 256; vw += G) {
            {
                const int b = vw >> 4, hp = (vw >> 2) & 3, j4 = vw & 3;
                const bf16_t* base = qkv + (size_t)b * SEQ * NQKV; bf16x8 qrm[4];
#pragma unroll 1
                for (int hh = 0; hh < 2; ++hh) { const int h = 2 * hp + hh;
                    __syncthreads();
                    for (int i = tid; i < 15 * 64; i += 512) { const float* kp = kmean + (size_t)(b * 16 + (i >> 6)) * 1024 + h * 64 + (i & 63); kml[i] = (kp[0] + kp[512]) * (1.0f / 256.0f); }
                    __syncthreads();
                    int slot0 = 0;
                    for (int i = 0; i < 4; ++i) { const int s = j4 + 4 * (i >> 1), qb = (i & 1) ? 15 - s : s; const int in = i + 1, sn = j4 + 4 * (in >> 1), qbn = (in & 1) ? 15 - sn : sn;
                        att::attn_unit<1, 8>(base + (size_t)qb * 256 * NQKV + QM_OFF + h * 64, base + KM_OFF + h * 64, base + VM_OFF + h * 64,
                                             ybuf + ((size_t)b * SEQ + qb * 256) * DM + 512 + h * 64, 4 * qb + 4, 256 * qb, tabM + h * 768, kml, nullptr, 0, shm,
                                             qrm, i == 0, i < 3, base + (size_t)(qbn & 15) * 256 * NQKV + QM_OFF + h * 64, base + KM_OFF + h * 64, base + VM_OFF + h * 64, 0, slot0); } }
            }
            {
                const int bk = vw >> 3, b = bk >> 1, kvh = bk & 1;
                const bf16_t* base = qkv + (size_t)b * SEQ * NQKV;
                bf16x8 qrs[4]; int slot0s = 0;
                for (int i = 0; i < 8; ++i) { const int jb = (vw & 7) * 8 + i, T0 = jb - 2, T1 = T0 + 1;
                    att::attn_unit<0, 8>(base + (size_t)jb * 64 * NQKV + QS_OFF + kvh * 256, base + (ptrdiff_t)T0 * 64 * NQKV + KS_OFF + kvh * 64, base + (ptrdiff_t)T0 * 64 * NQKV + VS_OFF + kvh * 64,
                                         ybuf + ((size_t)b * SEQ + jb * 64) * DM + kvh * 256, 3, 128, tabS + kvh * 4 * 320, kml, a.sinks + kvh * 4, T0 < 0 ? -T0 : 0, shm,
                                         qrs, i == 0, i < 7, base + (size_t)(jb + 1) * 64 * NQKV + QS_OFF + kvh * 256, base + (ptrdiff_t)T1 * 64 * NQKV + KS_OFF + kvh * 64, base + (ptrdiff_t)T1 * 64 * NQKV + VS_OFF + kvh * 64, T1 < 0 ? -T1 : 0, slot0s); }
            }
        }
#if PROBE_ATTN
        xcd_barrier(bar);
        { bf16_t* const yref = (bf16_t*)(ws + WS_PROBE); const size_t nth = (size_t)G * 512, t0 = (size_t)vcu * 512 + tid;
          for (size_t i = t0; i < (size_t)MTOK * DM / 2; i += nth) { const int n_ = *(const unsigned short*)(ybuf + 2 * i); const unsigned r_ = *(const unsigned*)(yref + 2 * i);
              *(unsigned*)(yref + 2 * i) = cvt_pk_bf16(__builtin_amdgcn_cvt_f32_fp8(n_, 0) * (1.0f / 64.0f) - bf_lo(r_), __builtin_amdgcn_cvt_f32_fp8(n_, 1) * (1.0f / 64.0f) - bf_hi(r_)); } }
#endif
    }
    SEAM(3);

    if (IN(4)) {
        ProbBranch P; P.KB = 512; P.A = (const char*)ybuf; P.WaT = (const char*)wa_t; P.WbT = (const char*)wb_t; P.S.init(MTOK, DM, G, bx); P.gates = gates; P.merged = merged;
        pg8::gemm_phase<ProbBranch>(lds, P);
    }
    SEAM(4);

    if (IN(5)) {
        ProbOut P; P.KB = DM; P.A = (const char*)merged; P.Bt = (const char*)wo_t; P.S.init(MTOK, DM, G, bx); P.h = hbuf;
        pg8::gemm_phase<ProbOut>(lds, P);
    }
    SEAM(5);

    if (IN(6)) {
        constexpr int WRS = 2064;
        for (int i = tid; i < 48 * 128; i += 512) { const int n = i >> 7, c = i & 127; *(LAS u32x4*)(lds + n * WRS + c * 16) = *(const u32x4*)(wr_t + (size_t)n * DM + c * 8); }
        LAS float* lg = (LAS float*)(lds + 100 * 1024) + wave * (16 * 52);
        LAS int* hist = (LAS int*)(lds + MOE_OFF); LAS int* hbase = hist + 32;
        f32x4 gn[4], bs[4];
#pragma unroll
        for (int j = 0; j < 4; ++j) { gn[j] = *(const f32x4*)(a.g1 + 4 * lane + 256 * j); bs[j] = *(const f32x4*)(a.b1 + 4 * lane + 256 * j); }
        __syncthreads();
        const int niter = (512 + G - 1) / G;
        for (int itr = 0; itr < niter; ++itr) {
            const int wb = itr * G + vcu; const bool act_wg = wb < 512;
            if (tid < 32) hist[tid] = 0;
            __syncthreads();
            int e1 = 0, e2 = 0, rk1 = 0, rk2 = 0, tok = 0; float w1 = 0.f, w2 = 0.f;
            if (act_wg) {
                const int row0 = (wb * 8 + wave) * 16;
                for (int r = 0; r < 16; ++r) { const size_t ro = (size_t)(row0 + r) * DM + 4 * lane; f32x4 v[4]; float s = 0.f;
#pragma unroll
                    for (int j = 0; j < 4; ++j) { const int hw = *(const int*)(hbuf + ro + 256 * j); const f32x4 xv = ldnt((const f32x4*)(a.x + ro + 256 * j));
                        v[j] = xv * ALPHA + (f32x4){fp8_at(hw, 0), fp8_at(hw, 1), fp8_at(hw, 2), fp8_at(hw, 3)} * (1.0f / 1024.0f); s += (v[j][0] + v[j][1]) + (v[j][2] + v[j][3]); }
                    const float mean = wave_sum(s) * (1.0f / DM); float s2 = 0.f;
#pragma unroll
                    for (int j = 0; j < 4; ++j) { v[j] = v[j] - mean; s2 += (v[j][0] * v[j][0] + v[j][1] * v[j][1]) + (v[j][2] * v[j][2] + v[j][3] * v[j][3]); }
                    const float rstd = 1.0f / sqrtf(wave_sum(s2) * (1.0f / DM) + LN_EPS);
#pragma unroll
                    for (int j = 0; j < 4; ++j) { const f32x4 o = v[j] * rstd * gn[j] + bs[j]; u32x2 w; w.x = cvt_pk_bf16(o[0], o[1]); w.y = cvt_pk_bf16(o[2], o[3]); *(u32x2*)(x1 + ro + 256 * j) = w;
                        *(unsigned*)(x1f8 + ro + 256 * j) = pk4_fp8(clampf(o[0] * 4.0f, -448.f, 448.f), clampf(o[1] * 4.0f, -448.f, 448.f), clampf(o[2] * 4.0f, -448.f, 448.f), clampf(o[3] * 4.0f, -448.f, 448.f)); } }
                asm volatile("s_waitcnt vmcnt(0)" ::: "memory");
                f32x4 ac[3]; ac[0] = (f32x4){0.f, 0.f, 0.f, 0.f}; ac[1] = ac[0]; ac[2] = ac[0];
                const bf16_t* arow = x1 + (size_t)(row0 + (lane & 15)) * DM + 8 * (lane >> 4);
                const LAS unsigned char* brow = lds + (lane & 15) * WRS + (lane >> 4) * 16;
#pragma unroll 8
                for (int s = 0; s < 32; ++s) { const bf16x8 af = *(const bf16x8*)(arow + 32 * s);
#pragma unroll
                    for (int c = 0; c < 3; ++c) { const bf16x8 bfr = *(const LAS bf16x8*)(brow + c * 16 * WRS + s * 64); ac[c] = __builtin_amdgcn_mfma_f32_16x16x32_bf16(bfr, af, ac[c], 0, 0, 0); } }
#pragma unroll
                for (int c = 0; c < 3; ++c)
#pragma unroll
                    for (int r = 0; r < 4; ++r) lg[(lane & 15) * 52 + 16 * c + 4 * (lane >> 4) + r] = ac[c][r];
                asm volatile("s_waitcnt lgkmcnt(0)" ::: "memory");
                if (lane < 16) {
                    const LAS float* L = lg + lane * 52; tok = row0 + lane;
                    float gl[4];
#pragma unroll
                    for (int i = 0; i < 4; ++i) gl[i] = L[i] + a.bgr[i];
                    int gi = 0; float gm = gl[0];
#pragma unroll
                    for (int i = 1; i < 4; ++i) if (gl[i] > gm) { gm = gl[i]; gi = i; }
                    float gs = 0.f;
#pragma unroll
                    for (int i = 0; i < 4; ++i) gs += __expf(gl[i] - gm);
                    const float gp = 1.0f / gs;
                    float el[8];
#pragma unroll
                    for (int i = 0; i < 8; ++i) el[i] = L[4 + 8 * gi + i] + a.ber[8 * gi + i];
                    int i1 = 0; float t1 = el[0];
#pragma unroll
                    for (int i = 1; i < 8; ++i) if (el[i] > t1) { t1 = el[i]; i1 = i; }
                    int i2 = -1; float t2 = -INFINITY;
#pragma unroll
                    for (int i = 0; i < 8; ++i) if (i != i1 && el[i] > t2) { t2 = el[i]; i2 = i; }
                    w1 = gp / (1.0f + __expf(t2 - t1)); w2 = gp - w1;
                    e1 = 8 * gi + i1; e2 = 8 * gi + i2;
                    rk1 = __hip_atomic_fetch_add(hist + e1, 1, __ATOMIC_RELAXED, __HIP_MEMORY_SCOPE_WORKGROUP);
                    rk2 = __hip_atomic_fetch_add(hist + e2, 1, __ATOMIC_RELAXED, __HIP_MEMORY_SCOPE_WORKGROUP);
                }
            }
            __syncthreads();
            if (tid < 32) { const int c = hist[tid]; hbase[tid] = c ? (int)__hip_atomic_fetch_add(ctl + CW_CNT + tid, (unsigned)c, RLX_AGENT) : 0; }
            __syncthreads();
            if (act_wg && lane < 16) {
                (void)__hip_atomic_exchange((unsigned long long*)(list + (size_t)e1 * MTOK + hbase[e1] + rk1), (unsigned long long)((unsigned)tok * 2u) | ((unsigned long long)__float_as_uint(w1) << 32), RLX_AGENT);
                (void)__hip_atomic_exchange((unsigned long long*)(list + (size_t)e2 * MTOK + hbase[e2] + rk2), (unsigned long long)((unsigned)tok * 2u + 1u) | ((unsigned long long)__float_as_uint(w2) << 32), RLX_AGENT);
            }
            __syncthreads();
        }
    }
    SEAM(6);

    MoeTab MT; MT.cnt = (const LAS int*)(lds + MOE_OFF); MT.pre = MT.cnt + 32; MT.te = (const LAS unsigned char*)(MT.pre + 36); MT.G = G; MT.vcu = vcu; MT.total_units = 0;
    if (IN(7) || IN(8)) {
        LAS int* mc = (LAS int*)(lds + MOE_OFF); LAS int* mp = mc + 32; LAS unsigned char* mt = (LAS unsigned char*)(mp + 36);
        __syncthreads();
        if (wave == 0) {
            const int c = (lane < NEXP) ? (int)__hip_atomic_load(ctl + CW_CNT + (lane & 31), RLX_AGENT) : 0; const int ntl = (c + 255) >> 8;
            int incl = ntl;
#pragma unroll
            for (int o = 1; o < 32; o <<= 1) { const int t = __shfl_up(incl, o); if (lane >= o) incl += t; }
            const int p = incl - ntl;
            if (lane < NEXP) { mc[lane] = c; mp[lane] = p; for (int k = 0; k < ntl; ++k) mt[p + k] = (unsigned char)lane; }
            if (lane == NEXP - 1) mp[32] = incl; }
        __syncthreads();
        MT.total_units = __builtin_amdgcn_readfirstlane(MT.pre[32]) * 4;
    }

    if (IN(7)) {
        ProbGateUp P; P.KB = DM; P.A = (const char*)x1f8; P.Bt = (const char*)gu_t; P.T = MT; P.list = list; P.act = act;
        pg8::gemm_phase<ProbGateUp>(lds, P);
    }
    SEAM(7);

    if (IN(8)) {
        ProbDown P; P.KB = DEXP; P.A = (const char*)act; P.Bt = (const char*)wd_t; P.T = MT; P.list = list; P.ys = ys;
        pg8::gemm_phase<ProbDown>(lds, P);
    }
    SEAM(8);

    if (IN(9)) {
        f32x4 gn[4], bs[4];
#pragma unroll
        for (int j = 0; j < 4; ++j) { gn[j] = *(const f32x4*)(a.g2 + 4 * lane + 256 * j); bs[j] = *(const f32x4*)(a.b2 + 4 * lane + 256 * j); }
        for (int row = gw; row < MTOK; row += NGW) { const size_t ro = (size_t)row * DM + 4 * lane; const size_t yo = (size_t)(2 * row) * DM + 4 * lane; f32x4 v[4]; float s = 0.f;
#pragma unroll
            for (int j = 0; j < 4; ++j) { const u32x2 xw = *(const u32x2*)(x1 + ro + 256 * j); const int y0 = *(const int*)(ys + yo + 256 * j), y1 = *(const int*)(ys + yo + DM + 256 * j);
                constexpr float YS = 1.0f / 128.0f;
                v[j][0] = ALPHA * bf_lo(xw.x) + (fp8_at(y0, 0) + fp8_at(y1, 0)) * YS; v[j][1] = ALPHA * bf_hi(xw.x) + (fp8_at(y0, 1) + fp8_at(y1, 1)) * YS;
                v[j][2] = ALPHA * bf_lo(xw.y) + (fp8_at(y0, 2) + fp8_at(y1, 2)) * YS; v[j][3] = ALPHA * bf_hi(xw.y) + (fp8_at(y0, 3) + fp8_at(y1, 3)) * YS;
                s += (v[j][0] + v[j][1]) + (v[j][2] + v[j][3]); }
            const float mean = wave_sum(s) * (1.0f / DM); float s2 = 0.f;
#pragma unroll
            for (int j = 0; j < 4; ++j) { v[j] = v[j] - mean; s2 += (v[j][0] * v[j][0] + v[j][1] * v[j][1]) + (v[j][2] * v[j][2] + v[j][3] * v[j][3]); }
            const float rstd = 1.0f / sqrtf(wave_sum(s2) * (1.0f / DM) + LN_EPS);
#pragma unroll
            for (int j = 0; j < 4; ++j) { f32x4 o_ = v[j] * rstd * gn[j] + bs[j];
#if PROBE_ATTN
                { const bf16_t* yr = (const bf16_t*)(ws + WS_PROBE); const int col = 4 * lane + 256 * j;
                  if (col >= PROBE_LO && col < PROBE_HI) { const u32x2 r_ = *(const u32x2*)(yr + ro + 256 * j);
                      o_[0] += PROBE_AMP * bf_lo(r_.x); o_[1] += PROBE_AMP * bf_hi(r_.x); o_[2] += PROBE_AMP * bf_lo(r_.y); o_[3] += PROBE_AMP * bf_hi(r_.y); } }
#endif
                st_wt16(a.out + ro + 256 * j, __builtin_bit_cast(u32x4, o_)); } }
    }
#undef IN
#undef SEAM
}

extern "C" void kernel_launch(void* const* d_in, const int* in_sizes, int n_in, void* d_out, int out_size, void* d_ws, size_t ws_size, hipStream_t stream) {
    static int grid = 0;
    if (grid == 0) {
        if (n_in != 19 || in_sizes[0] != MTOK * DM || out_size != MTOK * DM || ws_size < WS_END) { fprintf(stderr, "kernel_launch: unexpected shapes (n_in %d, in0 %d, out %d, ws %zu)\n", n_in, n_in > 0 ? in_sizes[0] : -1, out_size, ws_size); grid = -1; return; }
        int dev = 0, cus = 0, per_cu = 0;
        if (hipGetDevice(&dev) != hipSuccess || hipDeviceGetAttribute(&cus, hipDeviceAttributeMultiprocessorCount, dev) != hipSuccess) { grid = -1; return; }
        if (hipFuncSetAttribute((const void*)fwd_kernel, hipFuncAttributeMaxDynamicSharedMemorySize, LDS_BYTES) != hipSuccess) { fprintf(stderr, "kernel_launch: hipFuncSetAttribute failed\n"); grid = -1; return; }
        if (hipOccupancyMaxActiveBlocksPerMultiprocessor(&per_cu, (const void*)fwd_kernel, 512, LDS_BYTES) != hipSuccess || per_cu < 1) { fprintf(stderr, "kernel_launch: occupancy query reports %d\n", per_cu); }
        (void)hipGetLastError();
        grid = cus;
    }
    if (grid < 0) return;
    if (hipMemsetAsync((char*)d_ws + WS_CTL, 0, CTL_ZERO_BYTES, stream) != hipSuccess) return;
    Args a{};
    a.x = (const float*)d_in[0]; a.w_in = (const float*)d_in[1]; a.b_in = (const float*)d_in[2]; a.sinks = (const float*)d_in[3]; a.rel = (const float*)d_in[4];
    a.wa = (const float*)d_in[5]; a.wb = (const float*)d_in[6]; a.wo = (const float*)d_in[7]; a.g1 = (const float*)d_in[8]; a.b1 = (const float*)d_in[9];
    a.wgr = (const float*)d_in[10]; a.bgr = (const float*)d_in[11]; a.wer = (const float*)d_in[12]; a.ber = (const float*)d_in[13];
    a.wg = (const float*)d_in[14]; a.wu = (const float*)d_in[15]; a.wd = (const float*)d_in[16]; a.g2 = (const float*)d_in[17]; a.b2 = (const float*)d_in[18];
    a.out = (float*)d_out; a.ws = (unsigned char*)d_ws; a.pad = 0;
    if (MK_N_LAUNCHES == 1) { a.ph_lo = 0; a.ph_hi = NPHASE; a.li = 0; hipLaunchKernelGGL(fwd_kernel, dim3(grid), dim3(512), LDS_BYTES, stream, a); }
    else { for (int li = 0; li < NPHASE; ++li) for (int rep = 0; rep < (li == DUP_PHASE ? 2 : 1); ++rep) { a.ph_lo = li; a.ph_hi = li + 1; a.li = li; hipLaunchKernelGGL(fwd_kernel, dim3(grid), dim3(512), LDS_BYTES, stream, a); } }
    const hipError_t le = hipPeekAtLastError();
    if (le != hipSuccess) fprintf(stderr, "kernel_launch: launch failed: %s\n", hipGetErrorName(le));
}
```

```cpp
#include <hip/hip_runtime.h>
#include <cstdio>
#include <cstdint>

#define GAS __attribute__((address_space(1)))
#define LAS __attribute__((address_space(3)))
typedef unsigned short bf16_t;
typedef short bf16x8 __attribute__((ext_vector_type(8)));
typedef float f32x4 __attribute__((ext_vector_type(4)));
typedef float f32x2 __attribute__((ext_vector_type(2)));
typedef unsigned u32x4 __attribute__((ext_vector_type(4)));
typedef unsigned u32x2 __attribute__((ext_vector_type(2)));

#ifndef PROBE_ATTN
#define PROBE_ATTN 0
#endif
#define PROBE_AMP 1.0f
#define PROBE_LO 0
#define PROBE_HI 1024
#ifndef DUP_PHASE
#define DUP_PHASE -1
#endif
#ifndef MK_N_LAUNCHES
#define MK_N_LAUNCHES 1
#endif

constexpr int NBATCH = 16, SEQ = 4096, DM = 1024, MTOK = NBATCH * SEQ;
constexpr int NPROJ = 4352, NQKV = 2304, NGATE = 2048;
constexpr int QS_OFF = 0, KS_OFF = 512, VS_OFF = 640, QM_OFF = 768, KM_OFF = 1280, VM_OFF = 1792;
constexpr int NEXP = 32, DEXP = 512;
constexpr float LN_EPS = 1e-5f;
constexpr float ALPHA = 1.1892071150027210667f;
constexpr float LOG2E = 1.4426950408889634f;
constexpr float C2 = 0.125f * 1.4426950408889634f;
constexpr int NPHASE = 10;

constexpr size_t MiB = 1u << 20;
constexpr size_t WS_CTL = 0, CTL_ZERO_BYTES = 128 * 1024;
constexpr size_t WS_WIN_T = 2 * MiB;
constexpr size_t WS_WA_T = 11 * MiB;
constexpr size_t WS_WB_T = 12 * MiB;
constexpr size_t WS_WO_T = 13 * MiB;
constexpr size_t WS_WR_T = 15 * MiB;
constexpr size_t WS_GU_T = 16 * MiB;
constexpr size_t WS_WD_T = 80 * MiB;
constexpr size_t WS_LIST = 112 * MiB;
constexpr size_t WS_KMEAN = 96 * MiB;
constexpr size_t WS_R1 = 128 * MiB;
constexpr size_t WS_R2 = 256 * MiB;
constexpr size_t WS_R3 = 544 * MiB;
constexpr size_t WS_X1F8 = 800 * MiB;
constexpr size_t WS_PROBE = 864 * MiB;
constexpr size_t WS_END = PROBE_ATTN ? 992 * MiB : 864 * MiB;
constexpr int CW_BAR = 4096;
constexpr int CW_CNT = 16384;

constexpr int RING_BYTES = 131072;
constexpr int LDSCTL_OFF = RING_BYTES, MISC_OFF = LDSCTL_OFF + 320;
constexpr int MOE_OFF = LDSCTL_OFF + 1024;
constexpr int EPI_STG_OFF = LDSCTL_OFF + 2048, EPI_STG_WAVE = 2304;
constexpr int LDS_BYTES = EPI_STG_OFF + 8 * EPI_STG_WAVE;

#define RLX_AGENT __ATOMIC_RELAXED, __HIP_MEMORY_SCOPE_AGENT
__device__ __forceinline__ unsigned cvt_pk_bf16(float lo, float hi) { unsigned r; asm volatile("v_cvt_pk_bf16_f32 %0, %1, %2" : "=v"(r) : "v"(lo), "v"(hi)); return r; }
__device__ __forceinline__ float clampf(float v, float, float) { return v; }
__device__ __forceinline__ unsigned pk4_fp8(float a, float b, float c, float d) { const unsigned lo = (unsigned)__builtin_amdgcn_cvt_pk_fp8_f32(a, b, 0, false), hi = (unsigned)__builtin_amdgcn_cvt_pk_fp8_f32(c, d, 0, false); return (hi << 16) | lo; }
__device__ __forceinline__ float fp8_at(int w, int j) { return j == 0 ? __builtin_amdgcn_cvt_f32_fp8(w, 0) : j == 1 ? __builtin_amdgcn_cvt_f32_fp8(w, 1) : j == 2 ? __builtin_amdgcn_cvt_f32_fp8(w, 2) : __builtin_amdgcn_cvt_f32_fp8(w, 3); }
__device__ __forceinline__ float bf_lo(unsigned w) { return __uint_as_float(w << 16); }
__device__ __forceinline__ float bf_hi(unsigned w) { return __uint_as_float(w & 0xffff0000u); }
__device__ __forceinline__ float bf1(bf16_t b) { return __uint_as_float((unsigned)b << 16); }
template <class T> __device__ __forceinline__ T ldnt(const T* p) { return __builtin_nontemporal_load(p); }
template <class T> __device__ __forceinline__ void stnt(T* p, T v) { __builtin_nontemporal_store(v, p); }
__device__ __forceinline__ void st_wt16(void* p, u32x4 v) { asm volatile("global_store_dwordx4 %0, %1, off sc0 sc1\n\ts_nop 1" :: "v"(p), "v"(v) : "memory"); }
__device__ __forceinline__ float wave_sum(float v) {
#pragma unroll
    for (int o = 1; o < 64; o <<= 1) v += __shfl_xor(v, o);
    return v;
}
__device__ __forceinline__ float wave_max(float v) {
#pragma unroll
    for (int o = 1; o < 64; o <<= 1) v = fmaxf(v, __shfl_xor(v, o));
    return v;
}

namespace pg8 {
constexpr int BM = 256, BK = 64, HALF = 128, HTB = HALF * BK * 2, STAGE_BYTES = 8 * HTB, NXCD = 8, WGM = 8;
__host__ __device__ __forceinline__ int lds_byte(int r, int c) { const int st = (r >> 4) * 2 + (c >> 5), rr = r & 15, cc = c & 31, ob = rr * 64 + cc * 2; return st * 1024 + (ob ^ (((ob >> 9) & 1) << 5)); }
__host__ __device__ __forceinline__ void stage_rc(int b, int& R, int& C) { const int st = b / 1024, sb = b % 1024, swz = sb ^ (((sb >> 9) & 1) << 5); R = (st >> 1) * 16 + swz / 64; C = (st & 1) * 32 + (swz % 64) / 2; }
__host__ __device__ __forceinline__ int perm32(int rho) { const int n = rho >> 4, i = rho & 15; return 8 * (i >> 2) + 4 * n + (i & 3); }
__host__ __device__ __forceinline__ int perm128(int R) { return 64 * (R >> 5) + 16 * ((R & 15) >> 2) + 4 * ((R >> 4) & 1) + (R & 3); }

struct Unit { int pm, pn, aux, aux2; };
typedef int v4i __attribute__((ext_vector_type(4))); typedef int v8i __attribute__((ext_vector_type(8)));
__device__ __forceinline__ void mma8_fp8(f32x4 (&c)[4][2], const v8i (&A)[4], const v8i (&B)[2], int sw, int sx) {
    asm volatile("s_nop 1\n\t"
        "v_mfma_scale_f32_16x16x128_f8f6f4 %0, %12, %8, %0, %14, %15 op_sel_hi:[0,0,0]\n\t"
        "v_mfma_scale_f32_16x16x128_f8f6f4 %1, %13, %8, %1, %14, %15 op_sel_hi:[0,0,0]\n\t"
        "v_mfma_scale_f32_16x16x128_f8f6f4 %2, %12, %9, %2, %14, %15 op_sel_hi:[0,0,0]\n\t"
        "v_mfma_scale_f32_16x16x128_f8f6f4 %3, %13, %9, %3, %14, %15 op_sel_hi:[0,0,0]\n\t"
        "v_mfma_scale_f32_16x16x128_f8f6f4 %4, %12, %10, %4, %14, %15 op_sel_hi:[0,0,0]\n\t"
        "v_mfma_scale_f32_16x16x128_f8f6f4 %5, %13, %10, %5, %14, %15 op_sel_hi:[0,0,0]\n\t"
        "v_mfma_scale_f32_16x16x128_f8f6f4 %6, %12, %11, %6, %14, %15 op_sel_hi:[0,0,0]\n\t"
        "v_mfma_scale_f32_16x16x128_f8f6f4 %7, %13, %11, %7, %14, %15 op_sel_hi:[0,0,0]"
        : "+v"(c[0][0]), "+v"(c[0][1]), "+v"(c[1][0]), "+v"(c[1][1]), "+v"(c[2][0]), "+v"(c[2][1]), "+v"(c[3][0]), "+v"(c[3][1])
        : "v"(A[0]), "v"(A[1]), "v"(A[2]), "v"(A[3]), "v"(B[0]), "v"(B[1]), "v"(sw), "v"(sx));
}
__device__ __forceinline__ void mma8_fp8_z(f32x4 (&c)[4][2], const v8i (&A)[4], const v8i (&B)[2], int sw, int sx) {
    asm volatile("s_nop 1\n\t"
        "v_mfma_scale_f32_16x16x128_f8f6f4 %0, %12, %8, 0, %14, %15 op_sel_hi:[0,0,0]\n\t"
        "v_mfma_scale_f32_16x16x128_f8f6f4 %1, %13, %8, 0, %14, %15 op_sel_hi:[0,0,0]\n\t"
        "v_mfma_scale_f32_16x16x128_f8f6f4 %2, %12, %9, 0, %14, %15 op_sel_hi:[0,0,0]\n\t"
        "v_mfma_scale_f32_16x16x128_f8f6f4 %3, %13, %9, 0, %14, %15 op_sel_hi:[0,0,0]\n\t"
        "v_mfma_scale_f32_16x16x128_f8f6f4 %4, %12, %10, 0, %14, %15 op_sel_hi:[0,0,0]\n\t"
        "v_mfma_scale_f32_16x16x128_f8f6f4 %5, %13, %10, 0, %14, %15 op_sel_hi:[0,0,0]\n\t"
        "v_mfma_scale_f32_16x16x128_f8f6f4 %6, %12, %11, 0, %14, %15 op_sel_hi:[0,0,0]\n\t"
        "v_mfma_scale_f32_16x16x128_f8f6f4 %7, %13, %11, 0, %14, %15 op_sel_hi:[0,0,0]"
        : "+v"(c[0][0]), "+v"(c[0][1]), "+v"(c[1][0]), "+v"(c[1][1]), "+v"(c[2][0]), "+v"(c[2][1]), "+v"(c[3][0]), "+v"(c[3][1])
        : "v"(A[0]), "v"(A[1]), "v"(A[2]), "v"(A[3]), "v"(B[0]), "v"(B[1]), "v"(sw), "v"(sx));
}
template <bool B_> struct BoolC { static constexpr bool value = B_; };
template <bool NOPS> __device__ __forceinline__ void mma_settle(f32x4 (&c)[4][2]) {
    if constexpr (NOPS) asm volatile("s_nop 15\n\ts_nop 7" : "+v"(c[0][0]), "+v"(c[0][1]), "+v"(c[1][0]), "+v"(c[1][1]), "+v"(c[2][0]), "+v"(c[2][1]), "+v"(c[3][0]), "+v"(c[3][1]));
    else asm volatile("" : "+v"(c[0][0]), "+v"(c[0][1]), "+v"(c[1][0]), "+v"(c[1][1]), "+v"(c[2][0]), "+v"(c[2][1]), "+v"(c[3][0]), "+v"(c[3][1]));
}
template <int H> __device__ __forceinline__ bf16x8 half8(v8i x) { return __builtin_bit_cast(bf16x8, (v4i)(H ? __builtin_shufflevector(x, x, 4, 5, 6, 7) : __builtin_shufflevector(x, x, 0, 1, 2, 3))); }
__device__ __forceinline__ v8i cat8(bf16x8 a, bf16x8 b) { const v4i x = __builtin_bit_cast(v4i, a), y = __builtin_bit_cast(v4i, b); return __builtin_shufflevector(x, y, 0, 1, 2, 3, 4, 5, 6, 7); }

struct StaticOrder {
    int nM, nN, nwg, G, c;
    __device__ void init(int M, int N, int G_, int c_) { nM = M / BM; nN = N / BM; nwg = nM * nN; G = G_; c = c_; }
    __device__ bool next(int i, Unit& u) const {
        const long L = (long)i * G + c; if (L >= nwg) return false;
        int wgid = (int)L; { const int q = nwg / NXCD, r = nwg % NXCD, xcd = wgid % NXCD, off = wgid / NXCD; wgid = (xcd < r ? xcd * (q + 1) : r * (q + 1) + (xcd - r) * q) + off; }
        const int nig = WGM * nN, gid = wgid / nig, fm = gid * WGM, gsz = (nM - fm) < WGM ? (nM - fm) : WGM;
        u.pm = fm + ((wgid % nig) % gsz); u.pn = (wgid % nig) / gsz; u.aux = 0; u.aux2 = 0; return true;
    }
};

template <class P>
__device__ __forceinline__ void gemm_phase(LAS unsigned char* lds, const P& p) {
    const int tid = threadIdx.x, wid = __builtin_amdgcn_readfirstlane(tid >> 6), lane = tid & 63, wr = wid >> 2, wc = wid & 3, fr = lane & 15, fq = lane >> 4;
    constexpr bool FP8 = P::FP8;
    const int KB = p.KB, nt = KB / 128;
    unsigned voffB[2]; int stR[2], stC2[2];
#pragma unroll
    for (int i = 0; i < 2; ++i) { int R, C; stage_rc(tid * 16 + i * 8192, R, C); const int Rb = (int)P::PERM == 2 ? perm128(R) : (int)P::PERM == 1 ? ((R & ~31) + perm32(R & 31)) : R;
        voffB[i] = (unsigned)(Rb * KB + C * 2); stR[i] = R; stC2[i] = C * 2; }
    const size_t kstep = (size_t)(BK * 2);
    const size_t hstepB = (size_t)((int)P::PERM == 2 ? 8 : HALF) * KB;
    const unsigned ldsw = (unsigned)wid * 1024u;
    const int aoff = lds_byte(wr * 64 + fr, fq * 8), boff = lds_byte(wc * 32 + fr, fq * 8);
#define PG8_SA(b, h) (((b) * 2 + (h)) * HTB)
#define PG8_SB(b, h) ((4 + (b) * 2 + (h)) * HTB)
#define PG8_STAGE(bufoff, gbase, voff) do { _Pragma("unroll") for (int _i = 0; _i < 2; ++_i) \
        __builtin_amdgcn_global_load_lds((const unsigned*)((const char*)(gbase) + (voff)[_i]), (LAS unsigned*)(lds + (bufoff) + ldsw + _i * 8192), 16, 0, 0); } while (0)
#define PG8_LDA(dst, b, h) do { _Pragma("unroll") for (int m = 0; m < 4; ++m) dst[m] = cat8(*(const LAS bf16x8*)(lds + PG8_SA(b, h) + aoff + m * 2048), *(const LAS bf16x8*)(lds + PG8_SA(b, h) + aoff + m * 2048 + 1024)); } while (0)
#define PG8_LDB(dst, b, h) do { _Pragma("unroll") for (int n = 0; n < 2; ++n) dst[n] = cat8(*(const LAS bf16x8*)(lds + PG8_SB(b, h) + boff + n * 2048), *(const LAS bf16x8*)(lds + PG8_SB(b, h) + boff + n * 2048 + 1024)); } while (0)
#define PG8_MMA(ai, bj, At, Bt) do { __builtin_amdgcn_s_setprio(1); if constexpr (FP8) mma8_fp8(acc[ai][bj], At, Bt, sc_w, sc_x); else _Pragma("unroll") for (int m = 0; m < 4; ++m) _Pragma("unroll") for (int n = 0; n < 2; ++n) { \
        if constexpr (FP8) {} \
        else { acc[ai][bj][m][n] = __builtin_amdgcn_mfma_f32_16x16x32_bf16(half8<0>(Bt[n]), half8<0>(At[m]), acc[ai][bj][m][n], 0, 0, 0); \
               acc[ai][bj][m][n] = __builtin_amdgcn_mfma_f32_16x16x32_bf16(half8<1>(Bt[n]), half8<1>(At[m]), acc[ai][bj][m][n], 0, 0, 0); } } \
        __builtin_amdgcn_s_setprio(0); } while (0)
#define PG8_MMAZ(ai, bj, At, Bt) do { __builtin_amdgcn_s_setprio(1); mma8_fp8_z(acc[ai][bj], At, Bt, sc_w, sc_x); __builtin_amdgcn_s_setprio(0); } while (0)
#define PG8_WAIT_V(n) asm volatile("s_waitcnt vmcnt(" #n ")" ::: "memory")
#define PG8_WAIT_L(n) asm volatile("s_waitcnt lgkmcnt(" #n ")" ::: "memory")
#define PG8_BAR __builtin_amdgcn_s_barrier()
#define PG8_SCHED __builtin_amdgcn_sched_barrier(0)
#define PG8_AOFF(dst, u) do { _Pragma("unroll") for (int _h = 0; _h < 2; ++_h) _Pragma("unroll") for (int _i = 0; _i < 2; ++_i) dst[_h][_i] = p.a_rowoff(u, _h * HALF + stR[_i]) + (unsigned)stC2[_i]; } while (0)
    Unit cur, nxt; int ui = 0;
    if (!p.next(0, cur)) return;
    f32x4 acc[2][2][4][2];
#pragma unroll
    for (int a = 0; a < 2; ++a)
#pragma unroll
        for (int b = 0; b < 2; ++b)
#pragma unroll
            for (int m = 0; m < 4; ++m)
#pragma unroll
                for (int n = 0; n < 2; ++n) acc[a][b][m][n] = (f32x4){0.f, 0.f, 0.f, 0.f};
    int sc_w = P::SCALE, sc_x = 0x7f7f7f7f; asm volatile("" : "+v"(sc_w), "+v"(sc_x));
    v8i At[4], B0[2], B1[2];
    unsigned oc[2][2], on[2][2];
    PG8_AOFF(oc, cur);
    const char* const aB = p.A;
    const char* cB = p.b_ptr(cur);
    PG8_STAGE(PG8_SB(0, 0), cB, voffB); PG8_STAGE(PG8_SB(0, 1), cB + hstepB, voffB); PG8_STAGE(PG8_SA(0, 0), aB, oc[0]); PG8_STAGE(PG8_SA(0, 1), aB, oc[1]);
    if (wr == 1) PG8_BAR;
    PG8_WAIT_V(2); PG8_BAR;
    PG8_STAGE(PG8_SB(1, 0), cB + kstep, voffB); PG8_STAGE(PG8_SA(1, 0), aB + kstep, oc[0]); PG8_STAGE(PG8_SB(1, 1), cB + hstepB + kstep, voffB);
    PG8_WAIT_V(6); PG8_BAR;
    for (;;) {
        const bool has_next = p.next(ui + 1, nxt);
        const char* nB = cB;
        if (has_next) { PG8_AOFF(on, nxt); nB = p.b_ptr(nxt); }
        else {
#pragma unroll
            for (int h = 0; h < 2; ++h)
#pragma unroll
                for (int i = 0; i < 2; ++i) on[h][i] = oc[h][i];
        }
        auto kpair = [&](const int t, auto zf) __attribute__((always_inline)) {
            const bool last = (t == nt - 2);
            const char* a1 = aB + (size_t)(t + 1) * kstep;
            const char* a2 = last ? aB : aB + (size_t)(t + 2) * kstep; const char* b2 = last ? nB : cB + (size_t)(t + 2) * kstep;
            const char* a3 = a2 + kstep; const char* b3 = b2 + kstep;
            unsigned o2[2][2];
#pragma unroll
            for (int h = 0; h < 2; ++h)
#pragma unroll
                for (int i = 0; i < 2; ++i) o2[h][i] = last ? on[h][i] : oc[h][i];
            PG8_LDB(B0, 0, 0); PG8_LDB(B1, 0, 1); PG8_SCHED; PG8_LDA(At, 0, 0); PG8_STAGE(PG8_SA(1, 1), a1, oc[1]);
            PG8_WAIT_V(8); PG8_WAIT_L(0); PG8_BAR; if constexpr (decltype(zf)::value) { PG8_MMAZ(0, 0, At, B0); PG8_MMAZ(0, 1, At, B1); } else { PG8_MMA(0, 0, At, B0); PG8_MMA(0, 1, At, B1); } PG8_BAR; PG8_SCHED;
            PG8_LDA(At, 0, 1); PG8_STAGE(PG8_SB(0, 0), b2, voffB); PG8_STAGE(PG8_SB(0, 1), b2 + hstepB, voffB); PG8_STAGE(PG8_SA(0, 0), a2, o2[0]);
            PG8_WAIT_V(8); PG8_WAIT_L(0); PG8_BAR; if constexpr (decltype(zf)::value) { PG8_MMAZ(1, 0, At, B0); PG8_MMAZ(1, 1, At, B1); } else { PG8_MMA(1, 0, At, B0); PG8_MMA(1, 1, At, B1); } PG8_BAR; PG8_SCHED;
            PG8_LDB(B0, 1, 0); PG8_LDB(B1, 1, 1); PG8_SCHED; PG8_LDA(At, 1, 0); PG8_STAGE(PG8_SA(0, 1), a2, o2[1]);
            PG8_WAIT_V(8); PG8_WAIT_L(0); PG8_BAR; PG8_MMA(0, 0, At, B0); PG8_MMA(0, 1, At, B1); PG8_BAR; PG8_SCHED;
            PG8_LDA(At, 1, 1); PG8_STAGE(PG8_SB(1, 0), b3, voffB); PG8_STAGE(PG8_SB(1, 1), b3 + hstepB, voffB); PG8_STAGE(PG8_SA(1, 0), a3, o2[0]);
            PG8_WAIT_V(8); PG8_WAIT_L(0); PG8_BAR; PG8_MMA(1, 0, At, B0); PG8_MMA(1, 1, At, B1); PG8_BAR; PG8_SCHED;
        };
        if constexpr (P::ZFIRST) { kpair(0, BoolC<true>{}); for (int t = 2; t < nt; t += 2) kpair(t, BoolC<false>{}); }
        else { for (int t = 0; t < nt; t += 2) kpair(t, BoolC<false>{}); }
        typename P::Pre pq; p.pre(cur, pq, wr, wc, fr, fq); PG8_SCHED;
        if (wr == 0) PG8_BAR;
        if constexpr (FP8) { mma_settle<true>(acc[0][0]); mma_settle<false>(acc[0][1]); mma_settle<false>(acc[1][0]); mma_settle<false>(acc[1][1]); }
        const bool fin = p.epi(acc, cur, wr, wc, fr, fq, lds + EPI_STG_OFF + wid * EPI_STG_WAVE, pq);
        if (!has_next) break;
        if (fin && !P::ZFIRST) {
#pragma unroll
            for (int a = 0; a < 2; ++a)
#pragma unroll
                for (int b = 0; b < 2; ++b)
#pragma unroll
                    for (int m = 0; m < 4; ++m)
#pragma unroll
                        for (int n = 0; n < 2; ++n) acc[a][b][m][n] = (f32x4){0.f, 0.f, 0.f, 0.f};
        }
        cur = nxt; cB = nB; ++ui;
#pragma unroll
        for (int h = 0; h < 2; ++h)
#pragma unroll
            for (int i = 0; i < 2; ++i) oc[h][i] = on[h][i];
        if (wr == 1) PG8_BAR;
    }
    PG8_WAIT_V(0);
    PG8_BAR;
#undef PG8_SA
#undef PG8_SB
#undef PG8_STAGE
#undef PG8_LDA
#undef PG8_LDB
#undef PG8_MMA
#undef PG8_WAIT_V
#undef PG8_MMAZ
#undef PG8_WAIT_L
#undef PG8_BAR
#undef PG8_SCHED
#undef PG8_AOFF
}
}

#define XB_TMO      128
#define XB_XCNT(j)  (256  + 64 * (j))
#define XB_XSUB(j)  (1280 + 64 * (j))
#define XB_XGEN(j)  (2304 + 64 * (j))
#define XB_TOP      3328
#define XB_TOPGEN   3392
#define XCD_BAR_WORDS 3456
#define XB_SPIN_CAP (1u << 18)
__device__ __forceinline__ unsigned xb_ld(unsigned* p)              { return __hip_atomic_load(p, __ATOMIC_RELAXED, __HIP_MEMORY_SCOPE_AGENT); }
__device__ __forceinline__ unsigned xb_add(unsigned* p, unsigned v) { return __hip_atomic_fetch_add(p, v, __ATOMIC_RELAXED, __HIP_MEMORY_SCOPE_AGENT); }
__device__ __forceinline__ unsigned xb_xcc_id() { return (unsigned)__builtin_amdgcn_s_getreg((3 << 11) | 20) & 0xFu; }
#define XB_SPIN(cond, bar) do { unsigned _sp = 0; while (cond) { __builtin_amdgcn_s_sleep(1); \
    if ((++_sp & 255u) == 0u) { if (xb_ld(&(bar)[XB_TMO])) break; if (_sp > XB_SPIN_CAP) { atomicAdd(&(bar)[XB_TMO], 1u); break; } } } } while (0)
struct XcdBarrier { unsigned* bar; unsigned x; volatile LAS unsigned* st; };
__device__ __forceinline__ XcdBarrier xcd_barrier_post(unsigned* bar, volatile LAS unsigned* st) {
    XcdBarrier b; b.bar = bar; b.x = xb_xcc_id(); b.st = st;
    if (threadIdx.x == 0) (void)xb_add(&bar[XB_XCNT(b.x)], 1u);
    return b;
}
__device__ __forceinline__ void xcd_barrier_complete(unsigned* bar, unsigned x, unsigned& nloc, unsigned& nx) {
    const unsigned G = gridDim.x * gridDim.y * gridDim.z;
    unsigned sum, cnt, mine, sp = 0u;
    for (;;) {
        sum = 0u; cnt = 0u; mine = 0u;
#pragma unroll
        for (unsigned j = 0; j < 16; ++j) { const unsigned c = xb_ld(&bar[XB_XCNT(j)]); sum += c; cnt += (c > 0u) ? 1u : 0u; mine = (j == x) ? c : mine; }
        if (sum == G) break;
        __builtin_amdgcn_s_sleep(1);
        if ((++sp & 255u) == 0u) { if (xb_ld(&bar[XB_TMO])) break; if (sp > XB_SPIN_CAP) { atomicAdd(&bar[XB_TMO], 1u); break; } }
    }
    nloc = mine > 0u ? mine : 1u; nx = cnt > 0u ? cnt : 1u;
}
__device__ __forceinline__ void xcd_barrier(const XcdBarrier& b) {
    asm volatile("s_waitcnt vmcnt(0)" ::: "memory");
    __syncthreads();
    if (threadIdx.x == 0) {
        unsigned* bar = b.bar;
        __builtin_amdgcn_s_waitcnt(0);
        unsigned nloc = b.st[0], nx = b.st[1];
        if (nloc == 0u) { xcd_barrier_complete(bar, b.x, nloc, nx); b.st[0] = nloc; b.st[1] = nx; }
        const unsigned old = xb_add(&bar[XB_XSUB(b.x)], 1u);
        const unsigned gen = old / nloc;
        if (old + 1u == (gen + 1u) * nloc) {
            __builtin_amdgcn_fence(__ATOMIC_RELEASE, "agent");
            asm volatile("s_waitcnt vmcnt(0)" ::: "memory");
            const unsigned og = xb_add(&bar[XB_TOP], 1u);
            const unsigned tg = og / nx;
            if (og + 1u == (tg + 1u) * nx) xb_add(&bar[XB_TOPGEN], 1u);
            else XB_SPIN(xb_ld(&bar[XB_TOPGEN]) == tg, bar);
            __builtin_amdgcn_fence(__ATOMIC_ACQUIRE, "agent");
            xb_add(&bar[XB_XGEN(b.x)], 1u);
            asm volatile("s_waitcnt vmcnt(0)" ::: "memory");
        } else {
            XB_SPIN(xb_ld(&bar[XB_XGEN(b.x)]) == gen, bar);
            __builtin_amdgcn_fence(__ATOMIC_ACQUIRE, "agent");
            asm volatile("s_waitcnt vmcnt(0)" ::: "memory");
        }
    }
    __syncthreads();
}

struct Args {
    const float* x; const float* w_in; const float* b_in; const float* sinks; const float* rel; const float* wa; const float* wb; const float* wo;
    const float* g1; const float* b1; const float* wgr; const float* bgr; const float* wer; const float* ber; const float* wg; const float* wu; const float* wd;
    const float* g2; const float* b2; float* out; unsigned char* ws; int ph_lo, ph_hi, li, pad;
};

struct ProbInProj {
    static constexpr int PERM = 2; static constexpr bool FP8 = true; static constexpr bool ZFIRST = true; static constexpr int SCALE = 0x77777777;
    int KB; const char* A; const char* Bt; pg8::StaticOrder S; bf16_t* qkv; unsigned char* gates; const float* bias; float* kpart;
    __device__ __forceinline__ bool next(int i, pg8::Unit& u) const { return S.next(i, u); }
    __device__ __forceinline__ unsigned a_rowoff(const pg8::Unit& u, int row) const { return (unsigned)(u.pm * 256 + row) * (unsigned)DM; }
    __device__ __forceinline__ const char* b_ptr(const pg8::Unit& u) const { return Bt + (size_t)u.pn * 256 * DM; }
    struct Pre { f32x4 bv[2][2]; };
    __device__ __forceinline__ void pre(const pg8::Unit& u, Pre& q, int wr, int wc, int fr, int fq) const {
#pragma unroll
        for (int bj = 0; bj < 2; ++bj)
#pragma unroll
            for (int n = 0; n < 2; ++n) q.bv[bj][n] = *(const f32x4*)(bias + u.pn * 256 + wc * 64 + 16 * fq + 8 * bj + 4 * n);
    }
    __device__ __forceinline__ bool epi(f32x4 (&acc)[2][2][4][2], const pg8::Unit& u, int wr, int wc, int fr, int fq, LAS unsigned char* stg, const Pre& pq) const {
        const int pn = u.pn; const float sc = (pn == 0 || pn == 1 || pn == 3 || pn == 4) ? C2 : 1.0f;
        const int ct = wc * 64 + 16 * fq;
        const f32x4 (&bv)[2][2] = pq.bv;
        if (pn == 5 || pn == 6) {
#pragma unroll
            for (int bj = 0; bj < 2; ++bj)
#pragma unroll
                for (int n = 0; n < 2; ++n) { f32x4 s = (f32x4){0.f, 0.f, 0.f, 0.f};
#pragma unroll
                    for (int ai = 0; ai < 2; ++ai)
#pragma unroll
                        for (int m = 0; m < 4; ++m) s += acc[ai][bj][m][n];
#pragma unroll
                    for (int o = 1; o < 16; o <<= 1) { s[0] += __shfl_xor(s[0], o); s[1] += __shfl_xor(s[1], o); s[2] += __shfl_xor(s[2], o); s[3] += __shfl_xor(s[3], o); }
                    if (fr == 0) *(f32x4*)(kpart + ((size_t)u.pm * 2 + wr) * 512 + (pn - 5) * 256 + ct + 8 * bj + 4 * n) = s + bv[bj][n] * 128.0f; }
        }
#pragma unroll
        for (int ai = 0; ai < 2; ++ai)
#pragma unroll
            for (int m = 0; m < 4; ++m) { const size_t row = (size_t)(u.pm * 256 + ai * 128 + wr * 64 + m * 16 + fr);
                if (pn < 9) {
                    const int lane = fq * 16 + fr;
#pragma unroll
                    for (int bj = 0; bj < 2; ++bj) { const f32x4 v0 = (acc[ai][bj][m][0] + bv[bj][0]) * sc, v1 = (acc[ai][bj][m][1] + bv[bj][1]) * sc;
                        u32x4 w; w.x = cvt_pk_bf16(v0[0], v0[1]); w.y = cvt_pk_bf16(v0[2], v0[3]); w.z = cvt_pk_bf16(v1[0], v1[1]); w.w = cvt_pk_bf16(v1[2], v1[3]);
                        *(LAS u32x4*)(stg + fr * 144 + fq * 32 + bj * 16) = w; }
#pragma unroll
                    for (int hf = 0; hf < 2; ++hf) { const int rr = hf * 8 + (lane >> 3); const u32x4 w = *(const LAS u32x4*)(stg + rr * 144 + (lane & 7) * 16);
                        st_wt16(qkv + (size_t)(u.pm * 256 + ai * 128 + wr * 64 + m * 16 + rr) * NQKV + pn * 256 + wc * 64 + (lane & 7) * 8, w); } }
                else { unsigned char* rowp = gates + row * NGATE + (pn - 9) * 256 + ct;
                    u32x4 w;
#pragma unroll
                    for (int bj = 0; bj < 2; ++bj) { f32x4 v0 = (acc[ai][bj][m][0] + bv[bj][0]) * (-LOG2E), v1 = (acc[ai][bj][m][1] + bv[bj][1]) * (-LOG2E);
#pragma unroll
                        for (int e = 0; e < 4; ++e) { v0[e] = clampf(v0[e], -448.f, 448.f); v1[e] = clampf(v1[e], -448.f, 448.f); }
                        w[2 * bj] = pk4_fp8(v0[0], v0[1], v0[2], v0[3]); w[2 * bj + 1] = pk4_fp8(v1[0], v1[1], v1[2], v1[3]); }
                    *(u32x4*)rowp = w; } }
        return true;
    }
};

struct ProbBranch {
    static constexpr int PERM = 2; static constexpr bool FP8 = true; static constexpr bool ZFIRST = false; static constexpr int SCALE = 0x7B7B7B7B;
    int KB; const char* A; const char* WaT; const char* WbT; pg8::StaticOrder S; const unsigned char* gates; unsigned char* merged;
    __device__ __forceinline__ bool next(int i, pg8::Unit& u) const { const bool ok = S.next(i >> 1, u); u.aux = i & 1; return ok; }
    __device__ __forceinline__ unsigned a_rowoff(const pg8::Unit& u, int row) const { return (unsigned)(u.pm * 256 + row) * (unsigned)DM + (unsigned)u.aux * 512u; }
    __device__ __forceinline__ const char* b_ptr(const pg8::Unit& u) const { return (u.aux ? WbT : WaT) + (size_t)u.pn * 256 * 512; }
    struct Pre {};
    __device__ __forceinline__ void pre(const pg8::Unit&, Pre&, int, int, int, int) const {}
    __device__ __forceinline__ bool epi(f32x4 (&acc)[2][2][4][2], const pg8::Unit& u, int wr, int wc, int fr, int fq, LAS unsigned char* stg, const Pre& pq) const {
        const int ct = u.pn * 256 + wc * 64 + 16 * fq;
        if (u.aux == 0) {
#pragma unroll
            for (int ai = 0; ai < 2; ++ai)
#pragma unroll
                for (int m = 0; m < 4; ++m) { const unsigned char* gp = gates + (size_t)(u.pm * 256 + ai * 128 + wr * 64 + m * 16 + fr) * NGATE + ct;
                    const u32x4 ga = *(const u32x4*)gp, gb = *(const u32x4*)(gp + 1024);
#pragma unroll
                    for (int bj = 0; bj < 2; ++bj) {
                        const int gaw[2] = {(int)ga[2 * bj], (int)ga[2 * bj + 1]}, gbw[2] = {(int)gb[2 * bj], (int)gb[2 * bj + 1]};
#pragma unroll
                        for (int n = 0; n < 2; ++n)
#pragma unroll
                            for (int h = 0; h < 2; ++h) {
                                const f32x2 t1 = h ? __builtin_amdgcn_cvt_pk_f32_fp8(gaw[n], true) : __builtin_amdgcn_cvt_pk_f32_fp8(gaw[n], false);
                                const f32x2 t2 = h ? __builtin_amdgcn_cvt_pk_f32_fp8(gbw[n], true) : __builtin_amdgcn_cvt_pk_f32_fp8(gbw[n], false);
                                const f32x2 d1 = (f32x2){__builtin_amdgcn_exp2f(t1.x), __builtin_amdgcn_exp2f(t1.y)} + 1.0f;
                                const f32x2 d2 = (f32x2){__builtin_amdgcn_exp2f(t2.x), __builtin_amdgcn_exp2f(t2.y)} + 1.0f;
                                const f32x2 r = d2 * (f32x2){__builtin_amdgcn_rcpf(d1.x), __builtin_amdgcn_rcpf(d1.y)};
                                acc[ai][bj][m][n][2 * h] *= r.x; acc[ai][bj][m][n][2 * h + 1] *= r.y; } } }
            return false;
        }
#pragma unroll
        for (int ai = 0; ai < 2; ++ai)
#pragma unroll
            for (int m = 0; m < 4; ++m) { const size_t row = (size_t)(u.pm * 256 + ai * 128 + wr * 64 + m * 16 + fr); const unsigned char* gp = gates + row * NGATE + 1024 + ct; unsigned char* op = merged + row * DM + ct;
                const u32x4 gb = *(const u32x4*)gp; u32x4 w;
#pragma unroll
                for (int bj = 0; bj < 2; ++bj) { const int gbw[2] = {(int)gb[2 * bj], (int)gb[2 * bj + 1]}; float o[8];
#pragma unroll
                    for (int n = 0; n < 2; ++n)
#pragma unroll
                        for (int h = 0; h < 2; ++h) {
                            const f32x2 t2 = h ? __builtin_amdgcn_cvt_pk_f32_fp8(gbw[n], true) : __builtin_amdgcn_cvt_pk_f32_fp8(gbw[n], false);
                            const f32x2 d2 = (f32x2){__builtin_amdgcn_exp2f(t2.x), __builtin_amdgcn_exp2f(t2.y)} + 1.0f;
                            o[4 * n + 2 * h]     = clampf(acc[ai][bj][m][n][2 * h]     * __builtin_amdgcn_rcpf(d2.x), -448.f, 448.f);
                            o[4 * n + 2 * h + 1] = clampf(acc[ai][bj][m][n][2 * h + 1] * __builtin_amdgcn_rcpf(d2.y), -448.f, 448.f); }
                    w[2 * bj] = pk4_fp8(o[0], o[1], o[2], o[3]); w[2 * bj + 1] = pk4_fp8(o[4], o[5], o[6], o[7]); }
                *(u32x4*)op = w; }
        return true;
    }
};

struct ProbOut {
    static constexpr int PERM = 2; static constexpr bool FP8 = true; static constexpr bool ZFIRST = true; static constexpr int SCALE = 0x7A7A7A7A;
    int KB; const char* A; const char* Bt; pg8::StaticOrder S; unsigned char* h;
    __device__ __forceinline__ bool next(int i, pg8::Unit& u) const { return S.next(i, u); }
    __device__ __forceinline__ unsigned a_rowoff(const pg8::Unit& u, int row) const { return (unsigned)(u.pm * 256 + row) * (unsigned)DM; }
    __device__ __forceinline__ const char* b_ptr(const pg8::Unit& u) const { return Bt + (size_t)u.pn * 256 * DM; }
    struct Pre {};
    __device__ __forceinline__ void pre(const pg8::Unit&, Pre&, int, int, int, int) const {}
    __device__ __forceinline__ bool epi(f32x4 (&acc)[2][2][4][2], const pg8::Unit& u, int wr, int wc, int fr, int fq, LAS unsigned char* stg, const Pre& pq) const {
        const int ct = u.pn * 256 + wc * 64 + 16 * fq;
#pragma unroll
        for (int ai = 0; ai < 2; ++ai)
#pragma unroll
            for (int m = 0; m < 4; ++m) { const size_t off = (size_t)(u.pm * 256 + ai * 128 + wr * 64 + m * 16 + fr) * DM + ct; u32x4 w;
#pragma unroll
                for (int bj = 0; bj < 2; ++bj) { f32x4 v0 = acc[ai][bj][m][0], v1 = acc[ai][bj][m][1];
#pragma unroll
                    for (int e = 0; e < 4; ++e) { v0[e] = clampf(v0[e], -448.f, 448.f); v1[e] = clampf(v1[e], -448.f, 448.f); }
                    w[2 * bj] = pk4_fp8(v0[0], v0[1], v0[2], v0[3]); w[2 * bj + 1] = pk4_fp8(v1[0], v1[1], v1[2], v1[3]); }
                *(u32x4*)(h + off) = w; }
        return true;
    }
};

struct MoeTab { const LAS int* cnt; const LAS int* pre; const LAS unsigned char* te; int total_units; int G; int vcu; };
__device__ __forceinline__ bool moe_next(const MoeTab& T, int i, pg8::Unit& u) {
    const int L = i * T.G + T.vcu; if (L >= T.total_units) return false;
    const int rt = L >> 2; u.pn = L & 3;
    const int e = __builtin_amdgcn_readfirstlane((int)T.te[rt]); u.aux = e; u.pm = rt; u.aux2 = rt - __builtin_amdgcn_readfirstlane(T.pre[e]); return true;
}

struct ProbGateUp {
    static constexpr int PERM = 1; static constexpr bool FP8 = true; static constexpr bool ZFIRST = true; static constexpr int SCALE = 0x76767676;
    int KB; const char* A; const char* Bt; MoeTab T; const u32x2* list; unsigned char* act;
    __device__ __forceinline__ bool next(int i, pg8::Unit& u) const { return moe_next(T, i, u); }
    __device__ __forceinline__ unsigned a_rowoff(const pg8::Unit& u, int row) const {
        const int c = T.cnt[u.aux]; int r = u.aux2 * 256 + row; r = r < c ? r : c - 1;
        const unsigned aid = list[(size_t)u.aux * MTOK + r].x; return (aid >> 1) * (unsigned)DM;
    }
    __device__ __forceinline__ const char* b_ptr(const pg8::Unit& u) const { return Bt + ((size_t)u.aux * 4 + u.pn) * 256 * DM; }
    struct Pre { float wrow[2][4]; };
    __device__ __forceinline__ void pre(const pg8::Unit& u, Pre& q, int wr, int wc, int fr, int fq) const { const int c = T.cnt[u.aux];
#pragma unroll
        for (int ai = 0; ai < 2; ++ai)
#pragma unroll
            for (int m = 0; m < 4; ++m) { int r = u.aux2 * 256 + ai * 128 + wr * 64 + m * 16 + fr; r = r < c ? r : c - 1; q.wrow[ai][m] = __uint_as_float(list[(size_t)u.aux * MTOK + r].y) * 32.0f; }
    }
    __device__ __forceinline__ bool epi(f32x4 (&acc)[2][2][4][2], const pg8::Unit& u, int wr, int wc, int fr, int fq, LAS unsigned char* stg, const Pre& pq) const {
        const int ct = u.pn * 128 + wc * 32 + 8 * fq; const int c = T.cnt[u.aux];
        const float (&wrow)[2][4] = pq.wrow;
#pragma unroll
        for (int ai = 0; ai < 2; ++ai)
#pragma unroll
            for (int m = 0; m < 4; ++m) { unsigned char* op = act + (size_t)(u.pm * 256 + ai * 128 + wr * 64 + m * 16 + fr) * DEXP + ct; float o[8]; const float w32 = wrow[ai][m];
#pragma unroll
                for (int n = 0; n < 2; ++n)
#pragma unroll
                    for (int h = 0; h < 2; ++h) {
                        const f32x2 g = {acc[ai][0][m][n][2 * h], acc[ai][0][m][n][2 * h + 1]}, up = {acc[ai][1][m][n][2 * h], acc[ai][1][m][n][2 * h + 1]};
                        const f32x2 t = g * (-LOG2E);
                        const f32x2 d = (f32x2){__builtin_amdgcn_exp2f(t.x), __builtin_amdgcn_exp2f(t.y)} + 1.0f;
                        const f32x2 r = g * (f32x2){__builtin_amdgcn_rcpf(d.x), __builtin_amdgcn_rcpf(d.y)} * (up * w32);
                        o[4 * n + 2 * h] = clampf(r.x, -448.f, 448.f); o[4 * n + 2 * h + 1] = clampf(r.y, -448.f, 448.f); }
                u32x2 w; w.x = pk4_fp8(o[0], o[1], o[2], o[3]); w.y = pk4_fp8(o[4], o[5], o[6], o[7]);
                *(u32x2*)op = w; }
        return true;
    }
};

struct ProbDown {
    static constexpr int PERM = 2; static constexpr bool FP8 = true; static constexpr bool ZFIRST = true; static constexpr int SCALE = 0x7B7B7B7B;
    int KB; const char* A; const char* Bt; MoeTab T; const u32x2* list; unsigned char* ys;
    __device__ __forceinline__ bool next(int i, pg8::Unit& u) const { return moe_next(T, i, u); }
    __device__ __forceinline__ unsigned a_rowoff(const pg8::Unit& u, int row) const { return (unsigned)(u.pm * 256 + row) * (unsigned)DEXP; }
    __device__ __forceinline__ const char* b_ptr(const pg8::Unit& u) const { return Bt + ((size_t)u.aux * 4 + u.pn) * 256 * DEXP; }
    struct Pre { unsigned aidr[2][4]; };
    __device__ __forceinline__ void pre(const pg8::Unit& u, Pre& q, int wr, int wc, int fr, int fq) const { const int c = T.cnt[u.aux];
#pragma unroll
        for (int ai = 0; ai < 2; ++ai)
#pragma unroll
            for (int m = 0; m < 4; ++m) { int r = u.aux2 * 256 + ai * 128 + wr * 64 + m * 16 + fr; r = r < c ? r : c - 1; q.aidr[ai][m] = list[(size_t)u.aux * MTOK + r].x; }
    }
    __device__ __forceinline__ bool epi(f32x4 (&acc)[2][2][4][2], const pg8::Unit& u, int wr, int wc, int fr, int fq, LAS unsigned char* stg, const Pre& pq) const {
        const int ct = u.pn * 256 + wc * 64 + 16 * fq; const int c = T.cnt[u.aux];
        const unsigned (&aidr)[2][4] = pq.aidr;
#pragma unroll
        for (int ai = 0; ai < 2; ++ai)
#pragma unroll
            for (int m = 0; m < 4; ++m) { const int r = u.aux2 * 256 + ai * 128 + wr * 64 + m * 16 + fr;
                if (r < c) { unsigned char* op = ys + (size_t)aidr[ai][m] * DM + ct; u32x4 w;
#pragma unroll
                    for (int bj = 0; bj < 2; ++bj) { f32x4 v0 = acc[ai][bj][m][0], v1 = acc[ai][bj][m][1];
#pragma unroll
                        for (int e = 0; e < 4; ++e) { v0[e] = clampf(v0[e], -448.f, 448.f); v1[e] = clampf(v1[e], -448.f, 448.f); }
                        w[2 * bj] = pk4_fp8(v0[0], v0[1], v0[2], v0[3]); w[2 * bj + 1] = pk4_fp8(v1[0], v1[1], v1[2], v1[3]); }
                    *(u32x4*)op = w; } }
        return true;
    }
};

__device__ __forceinline__ void p0_transpose_item(const float* W, int N, int k0, int n0, bf16_t* dst0, int ldt, LAS float* scr, int lane) {
#pragma unroll 8
    for (int i = 0; i < 32; ++i) { const int kk = 2 * i + (lane >> 5); scr[kk * 33 + (lane & 31)] = W[(size_t)(k0 + kk) * N + n0 + (lane & 31)]; }
    asm volatile("s_waitcnt lgkmcnt(0)" ::: "memory");
    const int c = lane & 7;
#pragma unroll
    for (int j = 0; j < 4; ++j) { const int n = (lane >> 3) + 8 * j; const LAS float* s = scr + (8 * c) * 33 + n;
        u32x4 o; o.x = cvt_pk_bf16(s[0 * 33], s[1 * 33]); o.y = cvt_pk_bf16(s[2 * 33], s[3 * 33]); o.z = cvt_pk_bf16(s[4 * 33], s[5 * 33]); o.w = cvt_pk_bf16(s[6 * 33], s[7 * 33]);
        *(u32x4*)(dst0 + (size_t)n * ldt + 8 * c) = o; }
    asm volatile("s_waitcnt lgkmcnt(0)" ::: "memory");
}

__device__ __forceinline__ void p0_transpose_item_fp8(const float* W, int N, int k0, int n0, unsigned char* dst0, int ldt, LAS float* scr, int lane, float sc) {
#pragma unroll 8
    for (int i = 0; i < 32; ++i) { const int kk = 2 * i + (lane >> 5); scr[kk * 33 + (lane & 31)] = ldnt(W + (size_t)(k0 + kk) * N + n0 + (lane & 31)); }
    asm volatile("s_waitcnt lgkmcnt(0)" ::: "memory");
    const int n = lane >> 1;
#pragma unroll
    for (int j = 0; j < 2; ++j) { const int c = 2 * (lane & 1) + j; const LAS float* s = scr + (16 * c) * 33 + n; float v[16];
#pragma unroll
        for (int i = 0; i < 16; ++i) v[i] = clampf(s[i * 33] * sc, -448.f, 448.f);
        u32x4 o; o.x = pk4_fp8(v[0], v[1], v[2], v[3]); o.y = pk4_fp8(v[4], v[5], v[6], v[7]); o.z = pk4_fp8(v[8], v[9], v[10], v[11]); o.w = pk4_fp8(v[12], v[13], v[14], v[15]);
        *(u32x4*)(dst0 + (size_t)n * ldt + 16 * c) = o; }
    asm volatile("s_waitcnt lgkmcnt(0)" ::: "memory");
}

__device__ __forceinline__ int rel_bucket(int n) {
    if (n < 16) return n;
    int b = 16;
    b += (n >= 19) + (n >= 21) + (n >= 24) + (n >= 27) + (n >= 31) + (n >= 35) + (n >= 40) + (n >= 46) + (n >= 52) + (n >= 59) + (n >= 67) + (n >= 77) + (n >= 87) + (n >= 99) + (n >= 113);
    return b;
}


__device__ __forceinline__ void load_q64(const bf16_t* qp, float (&qf)[64]) {
#pragma unroll
    for (int c = 0; c < 8; ++c) { const u32x4 w = *(const u32x4*)(qp + 8 * c);
        qf[8 * c + 0] = bf_lo(w.x); qf[8 * c + 1] = bf_hi(w.x); qf[8 * c + 2] = bf_lo(w.y); qf[8 * c + 3] = bf_hi(w.y);
        qf[8 * c + 4] = bf_lo(w.z); qf[8 * c + 5] = bf_hi(w.z); qf[8 * c + 6] = bf_lo(w.w); qf[8 * c + 7] = bf_hi(w.w); }
}
__device__ __forceinline__ float dot64(const bf16_t* kp, const float (&qf)[64]) {
    float s0 = 0.f, s1 = 0.f;
#pragma unroll
    for (int c = 0; c < 8; ++c) { const u32x4 w = *(const u32x4*)(kp + 8 * c);
        s0 += qf[8 * c + 0] * bf_lo(w.x); s1 += qf[8 * c + 1] * bf_hi(w.x); s0 += qf[8 * c + 2] * bf_lo(w.y); s1 += qf[8 * c + 3] * bf_hi(w.y);
        s0 += qf[8 * c + 4] * bf_lo(w.z); s1 += qf[8 * c + 5] * bf_hi(w.z); s0 += qf[8 * c + 6] * bf_lo(w.w); s1 += qf[8 * c + 7] * bf_hi(w.w); }
    return s0 + s1;
}

namespace att {
using s16x4=__attribute__((ext_vector_type(4)))short;
using f32x16=__attribute__((ext_vector_type(16)))float;
constexpr int D=64,NW=8,QBLK=32,QB=256,KVBLK=64;
constexpr int QP=NQKV, OP=DM;
constexpr float OSC=64.f;
constexpr float BIG=30000.f;
__device__ __forceinline__ int crow(int r,int hi){return (r&3)+8*(r>>2)+4*hi;}
#define SBAR() __builtin_amdgcn_sched_barrier(0)
constexpr int NSLOT=3, SLOTB=8192;
constexpr int LDS_K=0, LDS_V=NSLOT*SLOTB, LDS_WS=2*NSLOT*SLOTB, LDS_OST=LDS_WS+NW*64*4, LDS_BYTES=LDS_OST+NW*4096, LDS_KM=90112, LDS_TS=94208, LDS_TM=104448;
__device__ __forceinline__ void glds16(const void*sbase,unsigned voff,unsigned lds_dst){unsigned keep;
  asm volatile("s_mov_b32 %0, m0\n\ts_mov_b32 m0, %2\n\ts_nop 2\n\tglobal_load_lds_dwordx4 %1, %3\n\ts_mov_b32 m0, %0":"=&s"(keep):"v"(voff),"s"(lds_dst),"s"(sbase):"memory");}
__device__ __forceinline__ float max3f(float a,float b,float c){float r;asm("v_max3_f32 %0, %1, %2, %3":"=v"(r):"v"(a),"v"(b),"v"(c));return r;}
__device__ __forceinline__ float max2f(float a,float b){float r;asm("v_max_f32_e32 %0, %1, %2":"=v"(r):"v"(a),"v"(b));return r;}
__device__ __forceinline__ float fadd_s(float a,float b){float r;asm("v_add_f32_e32 %0, %1, %2":"=v"(r):"v"(a),"v"(b));return r;}
__device__ __forceinline__ float fsub_s(float a,float b){float r;asm("v_sub_f32_e32 %0, %1, %2":"=v"(r):"v"(a),"v"(b));return r;}
typedef float f32x2_t __attribute__((ext_vector_type(2))); typedef __bf16 bf16x2_t __attribute__((ext_vector_type(2)));
__device__ __forceinline__ unsigned cvtpk_s(float lo,float hi){f32x2_t v={lo,hi};bf16x2_t b=__builtin_convertvector(v,bf16x2_t);return __builtin_bit_cast(unsigned,b);}
#define WAIT_BAR(N) asm volatile("s_waitcnt vmcnt(" #N ") lgkmcnt(0)\n\ts_barrier":::"memory")

__device__ __forceinline__ void qkt(f32x16&p0,f32x16&p1,const char*Kslot,const bf16x8*qr,const bf16x8 kones,const bf16x8 qaug,int r32,int hi){ const f32x16 negm=__builtin_amdgcn_mfma_f32_32x32x16_bf16(kones,qaug,f32x16{},0,0,0);
  const char*kb=Kslot+hi*1024+r32*16;
  #pragma unroll
  for(int d0=0;d0<4;++d0){
    const bf16x8 b0=*reinterpret_cast<const bf16x8*>(kb+d0*2048);
    const bf16x8 b1=*reinterpret_cast<const bf16x8*>(kb+d0*2048+512);
    if(d0==0){p0=__builtin_amdgcn_mfma_f32_32x32x16_bf16(b0,qr[0],negm,0,0,0);p1=__builtin_amdgcn_mfma_f32_32x32x16_bf16(b1,qr[0],negm,0,0,0);}
    else{p0=__builtin_amdgcn_mfma_f32_32x32x16_bf16(b0,qr[d0],p0,0,0,0);p1=__builtin_amdgcn_mfma_f32_32x32x16_bf16(b1,qr[d0],p1,0,0,0);}}
}
typedef __attribute__((address_space(3))) const char* lds_cptr;
typedef short v4i16_t __attribute__((ext_vector_type(4)));
__device__ __forceinline__ void kload8(bf16x8*kf,lds_cptr kp){
  kf[0]=*(const __attribute__((address_space(3))) bf16x8*)(kp);      kf[1]=*(const __attribute__((address_space(3))) bf16x8*)(kp+512);
  kf[2]=*(const __attribute__((address_space(3))) bf16x8*)(kp+2048); kf[3]=*(const __attribute__((address_space(3))) bf16x8*)(kp+2560);
  kf[4]=*(const __attribute__((address_space(3))) bf16x8*)(kp+4096); kf[5]=*(const __attribute__((address_space(3))) bf16x8*)(kp+4608);
  kf[6]=*(const __attribute__((address_space(3))) bf16x8*)(kp+6144); kf[7]=*(const __attribute__((address_space(3))) bf16x8*)(kp+6656);
}
__device__ __forceinline__ void kload2(bf16x8*kf,lds_cptr kp,int j){ kf[2*j]=*(const __attribute__((address_space(3))) bf16x8*)(kp+j*2048); kf[2*j+1]=*(const __attribute__((address_space(3))) bf16x8*)(kp+j*2048+512); }
__device__ __forceinline__ s16x4 vtr(lds_cptr p){ return __builtin_bit_cast(s16x4,__builtin_amdgcn_ds_read_tr16_b64_v4i16((__attribute__((address_space(3))) v4i16_t*)p)); }
__device__ __forceinline__ float rowmax(const f32x16&p0,const f32x16&p1){
  float a=max3f(p0[0],p0[1],p1[0]),b=max3f(p0[2],p0[3],p1[1]);a=max3f(a,p1[2],p1[3]);
  #pragma unroll
  for(int r=4;r<16;r+=4){a=max3f(a,p0[r],p0[r+1]);b=max3f(b,p0[r+2],p0[r+3]);a=max3f(a,p1[r],p1[r+1]);b=max3f(b,p1[r+2],p1[r+3]);}
  const float m=max2f(a,b);
  auto rr=__builtin_amdgcn_permlane32_swap(__float_as_uint(m),__float_as_uint(m),false,false);
  return max2f(__uint_as_float(rr[0]),__uint_as_float(rr[1]));
}
__device__ __forceinline__ void pv(f32x16*o,int vb,bf16x8 pa0,bf16x8 pa1,bf16x8 pa2,bf16x8 pa3){
  #pragma unroll
  for(int d0=0;d0<2;++d0){s16x4 lo[4],hi[4];
    #pragma unroll
    for(int ks=0;ks<4;++ks){
      asm volatile("ds_read_b64_tr_b16 %0,%1 offset:%c2":"=&v"(lo[ks]):"v"(vb),"i"(d0*4096+ks*1024):"memory");
      asm volatile("ds_read_b64_tr_b16 %0,%1 offset:%c2":"=&v"(hi[ks]):"v"(vb),"i"(d0*4096+ks*1024+512):"memory");}
    asm volatile("s_waitcnt lgkmcnt(0)":::"memory");SBAR();
    #define PK(k) (bf16x8){lo[k][0],lo[k][1],lo[k][2],lo[k][3],hi[k][0],hi[k][1],hi[k][2],hi[k][3]}
    o[d0]=__builtin_amdgcn_mfma_f32_32x32x16_bf16(pa0,PK(0),o[d0],0,0,0);
    o[d0]=__builtin_amdgcn_mfma_f32_32x32x16_bf16(pa1,PK(1),o[d0],0,0,0);
    o[d0]=__builtin_amdgcn_mfma_f32_32x32x16_bf16(pa2,PK(2),o[d0],0,0,0);
    o[d0]=__builtin_amdgcn_mfma_f32_32x32x16_bf16(pa3,PK(3),o[d0],0,0,0);
    #undef PK
  }
}

__device__ __forceinline__ void bandmask(f32x16&p0,f32x16&p1,const LAS float*tp){
  #pragma unroll
  for(int r=0;r<16;++r){ const int c=(r&3)+8*(r>>2); p0[r]+=tp[59-c]; p1[r]+=tp[27-c];
    if((r&3)==3){ asm volatile("":"+v"(p0),"+v"(p1)::"memory"); } }
}
#define ATTN_STORE16(p,v) st_wt16((p),(v))
template<class T> __device__ __forceinline__ T* uptr(T*p){ const unsigned long long v=(unsigned long long)p;
  return (T*)(((unsigned long long)(unsigned)__builtin_amdgcn_readfirstlane((int)(v>>32))<<32)|(unsigned long long)(unsigned)__builtin_amdgcn_readfirstlane((int)(unsigned)v)); }
template<int MODE,int THRL> __device__ __forceinline__ void attn_unit(const bf16_t*Qw0,const bf16_t*Kh_,const bf16_t*Vh_,unsigned char*Ow0,const int NT,const int q0rel,const LAS float*tab_,const LAS float*kml,const float*sinkp,const int tmin,char*shm,
    bf16x8 (&qr)[4],const bool first,const bool has_next,const bf16_t*Qn0,const bf16_t*Kn_,const bf16_t*Vn_,const int tminn,int&slot0){
  const bf16_t*const Kh=uptr(Kh_); const bf16_t*const Vh=uptr(Vh_); const bf16_t*const Kn=uptr(Kn_); const bf16_t*const Vn=uptr(Vn_);
  int tid_=threadIdx.x; asm volatile("":"+v"(tid_));
  const int tid=tid_,lane=tid&63,r32=lane&31,hi=lane>>5; const int wid=__builtin_amdgcn_readfirstlane(tid>>6);
  const bf16_t*Qw=(MODE==0)?Qw0+(long)((wid&1)*QBLK)*QP+(wid>>1)*D:Qw0+(long)(wid*QBLK)*QP;
  const LAS float*tab=(MODE==0)?tab_+(wid>>1)*320:tab_;
  const unsigned lds0=(unsigned)(uintptr_t)shm;
  float*wsf=(float*)(shm+LDS_WS)+wid*64;
  const int s0=(MODE==0)?0:slot0, s1=(s0==(NSLOT-1)*SLOTB)?0:s0+SLOTB, s2=(s1==(NSLOT-1)*SLOTB)?0:s1+SLOTB;
  const unsigned koff=(unsigned)(lane*QP+wid*8)*2u;
  const unsigned voffs=(unsigned)((16*(wid&3)+(lane>>2))*QP+(wid>>2)*32+(lane&3)*8)*2u;
  const unsigned kdst=lds0+LDS_K+wid*1024, vdst=lds0+LDS_V+wid*1024;
  #define TCL(t) ((MODE==0)?__builtin_amdgcn_readfirstlane((t)<tmin?tmin:(t)):(t))
  #define DMA_K(t,slot) glds16(Kh+(long)TCL(t)*KVBLK*QP,koff,(unsigned)__builtin_amdgcn_readfirstlane(kdst+(slot)))
  #define DMA_V(t,slot) glds16(Vh+(long)TCL(t)*KVBLK*QP,voffs,(unsigned)__builtin_amdgcn_readfirstlane(vdst+(slot)))
  const int vb0=(int)(lds0+LDS_V)+((lane>>4)&1)*32+(lane&3)*8+(4*hi+((lane&15)>>2))*64;
  const char*Kbase=shm+LDS_K+s0; bf16x8 kf[8];
  const lds_cptr shm3=(lds_cptr)shm; const lds_cptr kp0=shm3+LDS_K+hi*1024+r32*16; const lds_cptr vp0=shm3+LDS_V+((lane>>4)&1)*32+(lane&3)*8+(4*hi+((lane&15)>>2))*64;
  #define TCLN(t) ((MODE==0)?__builtin_amdgcn_readfirstlane((t)<tminn?tminn:(t)):(t))
  #define DMA_KN(t,slot) glds16(Kn+(long)TCLN(t)*KVBLK*QP,koff,(unsigned)__builtin_amdgcn_readfirstlane(kdst+(slot)))
  #define DMA_VN(t,slot) glds16(Vn+(long)TCLN(t)*KVBLK*QP,voffs,(unsigned)__builtin_amdgcn_readfirstlane(vdst+(slot)))
  if(first){
  DMA_K(0,s0);DMA_V(0,s0);DMA_K(1,s1);
  #pragma unroll
  for(int d0=0;d0<4;++d0)qr[d0]=*reinterpret_cast<const bf16x8*>(&Qw[(long)r32*QP+d0*16+hi*8]);
  }
  unsigned selmask=0u; float b31=0.f;
  if(MODE==1){ const int qb=(NT>>2)-1; b31=__uint_as_float(__builtin_amdgcn_readfirstlane(__float_as_uint(tab[256+127])));
    if(qb<=3) selmask=(1u<<qb)-1u;
    else{ float qv[32];
      #pragma unroll
      for(int d0=0;d0<4;++d0)
        #pragma unroll
        for(int e=0;e<8;++e)qv[d0*8+e]=__uint_as_float(((unsigned)(unsigned short)qr[d0][e])<<16);
      float v1=-INFINITY,v2=-INFINITY,v3=-INFINITY; int i1=0,i2=0,i3=0;
      for(int j=0;j<qb;++j){ const LAS float*km=kml+j*64+8*hi; float g=0.f;
        #pragma unroll
        for(int d0=0;d0<4;++d0){ const f32x4 ka=*(const LAS f32x4*)(km+16*d0), kb=*(const LAS f32x4*)(km+16*d0+4);
          g+=qv[d0*8+0]*ka[0]+qv[d0*8+1]*ka[1]+qv[d0*8+2]*ka[2]+qv[d0*8+3]*ka[3]+qv[d0*8+4]*kb[0]+qv[d0*8+5]*kb[1]+qv[d0*8+6]*kb[2]+qv[d0*8+7]*kb[3]; }
        g+=__shfl_xor(g,32);
        if(g>v1){v3=v2;i3=i2;v2=v1;i2=i1;v1=g;i1=j;} else if(g>v2){v3=v2;i3=i2;v2=g;i2=j;} else if(g>v3){v3=g;i3=j;} }
      selmask=(1u<<i1)|(1u<<i2)|(1u<<i3); } }
  #define ADDT(t) ((MODE==0)?(((t)<tmin)?-BIG:0.f):(((t)>=NT-4)?0.f:(((selmask>>((t)>>2))&1u)?(((t)<NT-6)?b31:0.f):-BIG)))
  float mhat=0.f,l_reg=0.f;f32x16 o[2];o[0]=f32x16{};o[1]=f32x16{};const f32x16 Z16=f32x16{};
  bf16x8 kones=bf16x8{}; { const short one_=(hi==0)?(short)0x3F80:(short)0; kones[0]=one_; kones[1]=one_; } asm volatile("":"+v"(kones));
  bf16x8 qaug=bf16x8{};
  #define SETAUG(t) do{ const float nm_=ADDT(t)-mhat; const unsigned h_=cvtpk_s(nm_,0.f)&0xffffu; const float l_=nm_-__uint_as_float(h_<<16); \
      const unsigned w_=(hi==0)?(h_|(cvtpk_s(l_,0.f)<<16)):0u; qaug[0]=(short)(w_&0xffffu); qaug[1]=(short)(w_>>16); }while(0)
  const int qpos=q0rel+((MODE==0)?(wid&1)*QBLK:wid*QBLK)+r32;
  const LAS float*const tpb=tab+((MODE==0)?64:256)+qpos-4*hi-59;
  #define CMASK(P0,P1,t) do{ if(MODE==0||(t)>=NT-6){ bandmask(P0,P1,tpb-64*(t)); } }while(0)
  bool resc=false;
  #define START(P0,P1) do{ const float rm=rowmax(P0,P1); resc=false; \
    { const float dl=__builtin_fmaxf(rm,0.f); mhat=dl; \
      _Pragma("unroll") for(int r=0;r<16;++r){P0[r]=fsub_s(P0[r],dl);P1[r]=fsub_s(P1[r],dl);} } \
    _Pragma("unroll") for(int r=0;r<16;++r)P0[r]=__builtin_amdgcn_exp2f(P0[r]); }while(0)
  #define RESC() do{ if(__builtin_expect(resc,0)){ asm volatile("s_waitcnt lgkmcnt(0)":::"memory"); \
      _Pragma("unroll") for(int d_=0;d_<2;++d_) _Pragma("unroll") for(int r=0;r<16;++r)o[d_][r]*=wsf[crow(r,hi)]; } }while(0)
  f32x16 pA0,pA1,pB0,pB1;
  int sl_prev=s0,sl_cur=s0,sl_next=s1;
  #define ROT() do{sl_prev=sl_cur;sl_cur=sl_next;sl_next=(sl_next==(NSLOT-1)*SLOTB)?0:sl_next+SLOTB;}while(0)
  if(first){DMA_K(2,s2);}
  WAIT_BAR(3);
  SETAUG(0); qkt(pA0,pA1,Kbase,qr,kones,qaug,r32,hi);asm volatile("s_nop 15\n\ts_nop 7":"+v"(pA0),"+v"(pA1));CMASK(pA0,pA1,0);
  asm volatile("s_nop 7":"+v"(pA0),"+v"(pA1));
  START(pA0,pA1);
  _Pragma("unroll") for(int r=0;r<16;++r)pA1[r]=__builtin_amdgcn_exp2f(pA1[r]);
  WAIT_BAR(0);
  if(MODE==1){DMA_K(3,s0);} DMA_V(1,s1);
  ROT();
  kload8(kf,kp0+sl_cur);
  WAIT_BAR(2);
  s16x4 vlo[8],vhi[8]; u32x4 pw0,pw1,pw2,pw3;
  #define PKW(P,B) cvtpk_s(P[B],P[B+1])
  #define PAF(k) __builtin_bit_cast(bf16x8,pw##k)
  #define VFR(i) (bf16x8){vlo[i][0],vlo[i][1],vlo[i][2],vlo[i][3],vhi[i][0],vhi[i][1],vhi[i][2],vhi[i][3]}
  #define PIN(x) asm volatile("":"+v"(x))
  #define MX3(a,b,c) __builtin_fmaxf(__builtin_fmaxf((a),(b)),(c))
  #define GAPA(MF,A0,A1,A2,A3,W0,W1,PW) do{ MF; sacc+=(f32x2_t){A0,A1}; sacc+=(f32x2_t){A2,A3}; PIN(sacc); W0; W1; PIN(PW); SBAR(); }while(0)
  #define EX(v) __builtin_amdgcn_exp2f(v)
  #define GAPB(MF,X,B) do{ MF; X[B]=EX(X[B]); X[B+1]=EX(X[B+1]); X[B+2]=EX(X[B+2]); X[B+3]=EX(X[B+3]); PIN(X); SBAR(); }while(0)
  #define VRD(i) do{ vlo[i]=vtr(vp_+(((i)>>2)*4096+((i)&3)*1024)); vhi[i]=vtr(vp_+(((i)>>2)*4096+((i)&3)*1024+512)); }while(0)
  #define KRD(G,j) do{ if(G){ kload2(kf,kp0+sl_next,j); SBAR(); } }while(0)
  #define STEP(C0,C1,P0,P1,t,GK,GV,GL,DOMASK,PF) do{ SETAUG(t); SBAR(); \
    C0=__builtin_amdgcn_mfma_f32_32x32x16_bf16(kones,qaug,Z16,0,0,0); C1=__builtin_amdgcn_mfma_f32_32x32x16_bf16(kones,qaug,Z16,0,0,0); SBAR(); \
    const lds_cptr vp_=vp0+sl_prev; \
    VRD(0); SBAR(); f32x2_t sacc=(f32x2_t){P0[0],P0[1]}; \
    GAPA(C0=__builtin_amdgcn_mfma_f32_32x32x16_bf16(kf[0],qr[0],C0,0,0,0), P0[2],P0[3],P0[4],P0[5],     pw0[0]=PKW(P0,0), pw0[1]=PKW(P0,2), pw0); \
    VRD(4); SBAR(); GAPA(C1=__builtin_amdgcn_mfma_f32_32x32x16_bf16(kf[1],qr[0],C1,0,0,0), P0[6],P0[7],P0[8],P0[9],     pw0[2]=PKW(P0,4), pw0[3]=PKW(P0,6), pw0); \
    VRD(1); SBAR(); GAPA(C0=__builtin_amdgcn_mfma_f32_32x32x16_bf16(kf[2],qr[1],C0,0,0,0),   P0[10],P0[11],P0[12],P0[13], pw1[0]=PKW(P0,8), pw1[1]=PKW(P0,10), pw1); \
    VRD(5); SBAR(); GAPA(C1=__builtin_amdgcn_mfma_f32_32x32x16_bf16(kf[3],qr[1],C1,0,0,0),   P0[14],P0[15],P1[0],P1[1],   pw1[2]=PKW(P0,12),pw1[3]=PKW(P0,14), pw1); \
    VRD(2); SBAR(); GAPA(C0=__builtin_amdgcn_mfma_f32_32x32x16_bf16(kf[4],qr[2],C0,0,0,0),   P1[2],P1[3],P1[4],P1[5],     pw2[0]=PKW(P1,0), pw2[1]=PKW(P1,2), pw2); \
    VRD(6); SBAR(); GAPA(C1=__builtin_amdgcn_mfma_f32_32x32x16_bf16(kf[5],qr[2],C1,0,0,0),   P1[6],P1[7],P1[8],P1[9],     pw2[2]=PKW(P1,4), pw2[3]=PKW(P1,6), pw2); \
    VRD(3); SBAR(); GAPA(C0=__builtin_amdgcn_mfma_f32_32x32x16_bf16(kf[6],qr[3],C0,0,0,0),   P1[10],P1[11],P1[12],P1[13], pw3[0]=PKW(P1,8), pw3[1]=PKW(P1,10), pw3); \
    VRD(7); SBAR(); GAPA(C1=__builtin_amdgcn_mfma_f32_32x32x16_bf16(kf[7],qr[3],C1,0,0,0),   P1[14],P1[15],0.f,0.f,       pw3[2]=PKW(P1,12),pw3[3]=PKW(P1,14), pw3); \
    l_reg+=sacc.x+sacc.y; \
    if(GK){DMA_K((t)+3,sl_cur);} if(GV){DMA_V((t)+1,sl_next);} PF \
    if(DOMASK){CMASK(C0,C1,t);} \
    { float a=MX3(C0[0],C0[1],C1[0]),b=MX3(C0[2],C0[3],C1[1]); a=MX3(a,C1[2],C1[3]); \
      _Pragma("unroll") for(int r=4;r<16;r+=4){a=MX3(a,C0[r],C0[r+1]);b=MX3(b,C0[r+2],C0[r+3]);a=MX3(a,C1[r],C1[r+1]);b=MX3(b,C1[r+2],C1[r+3]);} \
      float rm=__builtin_fmaxf(a,b); { auto rr=__builtin_amdgcn_permlane32_swap(__float_as_uint(rm),__float_as_uint(rm),false,false); rm=__builtin_fmaxf(__uint_as_float(rr[0]),__uint_as_float(rr[1])); } \
      resc=false; \
      if(__builtin_expect(__any(rm>(float)THRL),0)){ const float dl=__builtin_fmaxf(rm,0.f); mhat+=dl; \
        _Pragma("unroll") for(int r=0;r<16;++r){C0[r]-=dl;C1[r]-=dl;} \
        const float f=__builtin_amdgcn_exp2f(-dl); l_reg*=f; if(hi==0)wsf[r32]=f; resc=true; } } \
    SBAR(); \
    GAPB(o[0]=__builtin_amdgcn_mfma_f32_32x32x16_bf16(PAF(0),VFR(0),o[0],0,0,0), C0,0); \
    GAPB(o[1]=__builtin_amdgcn_mfma_f32_32x32x16_bf16(PAF(0),VFR(4),o[1],0,0,0), C0,4); \
    KRD(GL,0); GAPB(o[0]=__builtin_amdgcn_mfma_f32_32x32x16_bf16(PAF(1),VFR(1),o[0],0,0,0), C0,8); \
    KRD(GL,1); GAPB(o[1]=__builtin_amdgcn_mfma_f32_32x32x16_bf16(PAF(1),VFR(5),o[1],0,0,0), C0,12); \
    KRD(GL,2); GAPB(o[0]=__builtin_amdgcn_mfma_f32_32x32x16_bf16(PAF(2),VFR(2),o[0],0,0,0), C1,0); \
    KRD(GL,3); GAPB(o[1]=__builtin_amdgcn_mfma_f32_32x32x16_bf16(PAF(2),VFR(6),o[1],0,0,0), C1,4); \
    GAPB(o[0]=__builtin_amdgcn_mfma_f32_32x32x16_bf16(PAF(3),VFR(3),o[0],0,0,0), C1,8); \
    GAPB(o[1]=__builtin_amdgcn_mfma_f32_32x32x16_bf16(PAF(3),VFR(7),o[1],0,0,0), C1,12); \
    }while(0)
  #define DRAIN(X0,X1) do{ float sacc=X0[0]+X0[1]; _Pragma("unroll") for(int r=2;r<16;++r)sacc+=X0[r]; _Pragma("unroll") for(int r=0;r<16;++r)sacc+=X1[r]; l_reg+=sacc; \
    pw0=(u32x4){PKW(X0,0),PKW(X0,2),PKW(X0,4),PKW(X0,6)};pw1=(u32x4){PKW(X0,8),PKW(X0,10),PKW(X0,12),PKW(X0,14)};pw2=(u32x4){PKW(X1,0),PKW(X1,2),PKW(X1,4),PKW(X1,6)};pw3=(u32x4){PKW(X1,8),PKW(X1,10),PKW(X1,12),PKW(X1,14)}; \
    SBAR(); pv(o,vb0+sl_cur,PAF(0),PAF(1),PAF(2),PAF(3)); }while(0)
  #define NEXTPF() do{ if(has_next){ DMA_KN(0,sl_next);DMA_VN(0,sl_next);DMA_KN(1,sl_prev);DMA_KN(2,sl_cur); slot0=sl_next; \
      const bf16_t*Qnw=(MODE==0)?Qn0+(long)((wid&1)*QBLK)*QP+(wid>>1)*D:Qn0+(long)(wid*QBLK)*QP; \
      _Pragma("unroll") for(int d0=0;d0<4;++d0)qr[d0]=*reinterpret_cast<const bf16x8*>(&Qnw[(long)r32*QP+d0*16+hi*8]); } }while(0)
  if(MODE==0){
    STEP(pB0,pB1,pA0,pA1,1,false,true,true,true,);   WAIT_BAR(0); RESC(); ROT();
    STEP(pA0,pA1,pB0,pB1,2,false,false,false,true,NEXTPF();); RESC();
    DRAIN(pA0,pA1);
  } else {
  int t=1;
  for(;t+7<NT;t+=2){
    STEP(pB0,pB1,pA0,pA1,t,true,true,true,false,);     WAIT_BAR(2); RESC(); ROT();
    STEP(pA0,pA1,pB0,pB1,t+1,true,true,true,false,);   WAIT_BAR(2); RESC(); ROT();
  }
  #define ENDW(tt) do{ if((tt)+3<NT){WAIT_BAR(2);} else if((tt)+2<NT){WAIT_BAR(1);} else {WAIT_BAR(0);} }while(0)
  for(;t+1<NT;t+=2){
    STEP(pB0,pB1,pA0,pA1,t,(t+3<NT),(t+1<NT),(t+1<NT),true,);       ENDW(t);   RESC(); ROT();
    STEP(pA0,pA1,pB0,pB1,t+1,(t+4<NT),(t+2<NT),(t+2<NT),true,);     ENDW(t+1); RESC(); ROT();
  }
  STEP(pB0,pB1,pA0,pA1,NT-1,false,false,false,true,NEXTPF();); RESC();
  DRAIN(pB0,pB1);
  }
  #undef DRAIN
  #undef NEXTPF
  #undef DMA_KN
  #undef DMA_VN
  #undef TCLN
  #undef PKW
  #undef PAF
  #undef VFR
  #undef PIN
  #undef MX3
  #undef GAPA
  #undef GAPB
  #undef EX
  #undef VRD
  #undef KRD
  #undef STEP
  #undef ENDW
  {auto rr=__builtin_amdgcn_permlane32_swap(__float_as_uint(l_reg),__float_as_uint(l_reg),false,false);l_reg=__uint_as_float(rr[0])+__uint_as_float(rr[1]);}
  if(MODE==0)l_reg+=__builtin_amdgcn_exp2f(sinkp[wid>>1]*LOG2E-mhat);
  if(hi==0)wsf[32+r32]=l_reg;asm volatile("s_waitcnt lgkmcnt(0)":::"memory");
  float rli[16];
  #pragma unroll
  for(int r=0;r<16;++r)rli[r]=__builtin_amdgcn_rcpf(wsf[32+crow(r,hi)]);
  unsigned char*Ow=(MODE==0)?Ow0+(long)((wid&1)*QBLK)*OP+(wid>>1)*D:Ow0+(long)(wid*QBLK)*OP;
  { unsigned char*stg=(unsigned char*)(shm+LDS_OST)+wid*4096;
    #pragma unroll
    for(int r=0;r<16;++r){const int orow=crow(r,hi); const float sc_=rli[r]*OSC;
      #pragma unroll
      for(int d0=0;d0<2;++d0){ const float v_=__builtin_fminf(__builtin_fmaxf(o[d0][r]*sc_,-448.f),448.f); stg[orow*64+d0*32+r32]=(unsigned char)(__builtin_amdgcn_cvt_pk_fp8_f32(v_,0.f,0,false)&0xff); } }
    asm volatile("s_waitcnt lgkmcnt(0)":::"memory");
    #pragma unroll
    for(int i=0;i<2;++i){const int row=i*16+(lane>>2),ch=lane&3; const u32x4 v=*(const u32x4*)(stg+row*64+ch*16); ATTN_STORE16(Ow+(long)row*OP+ch*16,v);} }
  asm volatile("s_waitcnt lgkmcnt(0)\n\ts_barrier":::"memory");
  #undef DMA_K
  #undef DMA_V
  #undef TCL
  #undef CMASK
  #undef START
  #undef RESC
  #undef ROT
  #undef ADDT
  #undef SETAUG
}
#undef SBAR
#undef WAIT_BAR
}

__global__ void __launch_bounds__(512, 2) fwd_kernel(Args a) {
    extern __shared__ __attribute__((aligned(16))) unsigned char lds_raw[];
    LAS unsigned char* lds = (LAS unsigned char*)lds_raw;
    volatile LAS unsigned* MISC = (volatile LAS unsigned*)(lds + MISC_OFF);
    const int tid = threadIdx.x, lane = tid & 63, wave = __builtin_amdgcn_readfirstlane(tid >> 6);
    const int G = gridDim.x; const int bx = blockIdx.x; const int vcu = (G % 8 == 0) ? (bx % 8) * (G / 8) + bx / 8 : bx;
    unsigned char* ws = a.ws;
    unsigned* ctl = (unsigned*)(ws + WS_CTL);
    for (int u = tid; u < (LDS_BYTES - LDSCTL_OFF) / 4; u += 512) ((LAS unsigned*)(lds + LDSCTL_OFF))[u] = 0u;
    __syncthreads();
    __builtin_amdgcn_s_setreg(1 | (23 << 6) | (0 << 11), 1);
    bool sat_ok; { float big = 1000.0f; asm volatile("s_nop 3" : "+v"(big)); sat_ok = ((__builtin_amdgcn_cvt_pk_fp8_f32(big, -big, 0, false) & 0xffff) == 0xFE7E); }
    XcdBarrier bar; bar.bar = ctl + CW_BAR; bar.x = 0; bar.st = nullptr;
    if (MK_N_LAUNCHES == 1) bar = xcd_barrier_post(ctl + CW_BAR, MISC + 8);
    const int lo = a.ph_lo, hi = a.ph_hi;
#define IN(k) (lo <= (k) && (k) < hi)
#define SEAM(k) do { if (IN(k) && IN((k) + 1)) xcd_barrier(bar); } while (0)

    unsigned char* const win_t = ws + WS_WIN_T; unsigned char* const wa_t = ws + WS_WA_T; unsigned char* const wb_t = ws + WS_WB_T;
    unsigned char* const wo_t = ws + WS_WO_T; bf16_t* const wr_t = (bf16_t*)(ws + WS_WR_T); unsigned char* const gu_t = ws + WS_GU_T; unsigned char* const wd_t = ws + WS_WD_T; unsigned char* const x1f8 = ws + WS_X1F8;
    u32x2* const list = (u32x2*)(ws + WS_LIST); float* const kmean = (float*)(ws + WS_KMEAN);
    unsigned char* const x8 = ws + WS_R1; unsigned char* const ybuf = ws + WS_R1; bf16_t* const x1 = (bf16_t*)(ws + WS_R1);
    bf16_t* const qkv = (bf16_t*)(ws + WS_R2); unsigned char* const merged = ws + WS_R2; unsigned char* const act = ws + WS_R2;
    unsigned char* const gates = ws + WS_R3; unsigned char* const hbuf = ws + WS_R3; unsigned char* const ys = ws + WS_R3;
    const int gw = vcu * 8 + wave, NGW = G * 8;

    if (IN(0)) {
        LAS float* scr = (LAS float*)(lds + wave * 16384);
        constexpr int I_IN = 8 * 136, I_WA = 4 * 32, I_WO = 8 * 32, I_E = 128;
        constexpr int NIT = I_IN + 2 * I_WA + I_WO + 3 * NEXP * I_E;
        for (int it = gw; it < NIT; it += NGW) {
            int r = it;
            if (r < I_IN) { const int kb = r / 136, nb = r % 136;
#pragma unroll 1
                for (int h = 0; h < 2; ++h) p0_transpose_item_fp8(a.w_in, NPROJ, 128 * kb + 64 * h, 32 * nb, win_t + (size_t)(32 * nb) * DM + 128 * kb + 64 * h, DM, scr, lane, 64.0f);
                continue; } r -= I_IN;
            if (r < I_WA) { const int kb = r / 32, nb = r % 32;
#pragma unroll 1
                for (int h = 0; h < 2; ++h) p0_transpose_item_fp8(a.wa, DM, 128 * kb + 64 * h, 32 * nb, wa_t + (size_t)(32 * nb) * 512 + 128 * kb + 64 * h, 512, scr, lane, 64.0f);
                continue; } r -= I_WA;
            if (r < I_WA) { const int kb = r / 32, nb = r % 32;
#pragma unroll 1
                for (int h = 0; h < 2; ++h) p0_transpose_item_fp8(a.wb, DM, 128 * kb + 64 * h, 32 * nb, wb_t + (size_t)(32 * nb) * 512 + 128 * kb + 64 * h, 512, scr, lane, 64.0f);
                continue; } r -= I_WA;
            if (r < I_WO) { const int kb = r / 32, nb = r % 32;
#pragma unroll 1
                for (int h = 0; h < 2; ++h) p0_transpose_item_fp8(a.wo, DM, 128 * kb + 64 * h, 32 * nb, wo_t + (size_t)(32 * nb) * DM + 128 * kb + 64 * h, DM, scr, lane, 128.0f);
                continue; } r -= I_WO;
            if (r < 2 * NEXP * I_E) {
                const int up = r >= NEXP * I_E; if (up) r -= NEXP * I_E;
                const int e = r / I_E, q = r % I_E, kb = q / 16, nb = q % 16, n0 = 32 * nb;
                const float* W = (up ? a.wu : a.wg) + (size_t)e * DM * DEXP;
                unsigned char* dst = gu_t + ((size_t)e * 1024 + (n0 >> 7) * 256 + up * 128 + (n0 & 127)) * DM + 128 * kb;
#pragma unroll 1
                for (int h = 0; h < 2; ++h) p0_transpose_item_fp8(W, DEXP, 128 * kb + 64 * h, n0, dst + 64 * h, DM, scr, lane, 128.0f);
                continue; }
            r -= 2 * NEXP * I_E;
            { const int e = r / I_E, q = r % I_E, kb = q / 32, nb = q % 32;
#pragma unroll 1
              for (int h = 0; h < 2; ++h) p0_transpose_item_fp8(a.wd + (size_t)e * DEXP * DM, DM, 128 * kb + 64 * h, 32 * nb, wd_t + ((size_t)e * DM + 32 * nb) * DEXP + 128 * kb + 64 * h, DEXP, scr, lane, 64.0f); }
        }
        { const size_t nth = (size_t)G * 512, t0 = (size_t)vcu * 512 + tid;
          for (size_t i = t0; i < (size_t)MTOK * DM / 16; i += nth) { f32x4 v[4];
#pragma unroll
              for (int j = 0; j < 4; ++j) { v[j] = ldnt((const f32x4*)(a.x + i * 16 + 4 * j)) * 4.0f;
#pragma unroll
                  for (int e = 0; e < 4; ++e) v[j][e] = clampf(v[j][e], -448.f, 448.f); }
              u32x4 w; w.x = pk4_fp8(v[0][0], v[0][1], v[0][2], v[0][3]); w.y = pk4_fp8(v[1][0], v[1][1], v[1][2], v[1][3]); w.z = pk4_fp8(v[2][0], v[2][1], v[2][2], v[2][3]); w.w = pk4_fp8(v[3][0], v[3][1], v[3][2], v[3][3]);
              st_wt16(x8 + i * 16, w); } }
        { const int nth = G * 512, t0 = vcu * 512 + tid;
          for (int i = t0; i < 48 * DM / 2; i += nth) { const int n = i / (DM / 2), k = (i % (DM / 2)) * 2; float v0 = 0.f, v1 = 0.f;
              if (n < 4) { v0 = a.wgr[k * 4 + n]; v1 = a.wgr[(k + 1) * 4 + n]; } else if (n < 36) { v0 = a.wer[k * 32 + n - 4]; v1 = a.wer[(k + 1) * 32 + n - 4]; }
              *(unsigned*)(wr_t + (size_t)n * DM + k) = cvt_pk_bf16(v0, v1); } }
    }
    SEAM(0);

    if (IN(1)) {
        ProbInProj P; P.KB = DM; P.A = (const char*)x8; P.Bt = (const char*)win_t; P.S.init(MTOK, NPROJ, G, bx); P.qkv = qkv; P.gates = gates; P.bias = a.b_in; P.kpart = kmean;
        pg8::gemm_phase<ProbInProj>(lds, P);
    }
    SEAM(1);


    if (IN(3)) {
        char* shm = (char*)lds_raw;
        LAS float* tabS = (LAS float*)(lds + att::LDS_TS);
        LAS float* tabM = (LAS float*)(lds + att::LDS_TM);
        LAS float* kml = (LAS float*)(lds + att::LDS_KM);
        for (int i = tid; i < 8 * 320; i += 512) { const int h = i / 320, d = i % 320 - 64; tabS[i] = (d >= 0 && d < 128) ? a.rel[rel_bucket(d) * 16 + h] * LOG2E : -att::BIG; }
        for (int i = tid; i < 8 * 768; i += 512) { const int h = i / 768, d = i % 768 - 256; tabM[i] = (d >= 0) ? a.rel[rel_bucket(d < 127 ? d : 127) * 16 + 8 + h] * LOG2E : -att::BIG; }
        __syncthreads();
#if PROBE_ATTN
        { bf16_t* const yref = (bf16_t*)(ws + WS_PROBE); LAS float* tabn = (LAS float*)lds;
          for (int i = tid; i < 16 * 128; i += 512) { const int h = i >> 7, d = i & 127; tabn[i] = a.rel[rel_bucket(d) * 16 + h] * LOG2E; }
          __syncthreads();
        for (int it = gw; it < MTOK * 8; it += NGW) {
            const int hh = it & 7, m = it >> 3, t = m & (SEQ - 1), b = m >> 12;
            {
                const int kvh = hh >> 2; float qf[64]; load_q64(qkv + (size_t)m * NQKV + QS_OFF + hh * 64, qf);
                float s[2];
#pragma unroll
                for (int c = 0; c < 2; ++c) { const int kv = t - 127 + 64 * c + lane; const bool valid = kv >= 0; const int kvc = valid ? kv : 0;
                    const float d = dot64(qkv + (size_t)(b * SEQ + kvc) * NQKV + KS_OFF + kvh * 64, qf);
                    s[c] = valid ? d + tabn[hh * 128 + (t - kvc)] : -1e30f; }
                const float sink2 = a.sinks[hh] * LOG2E;
                const float mx = fmaxf(wave_max(fmaxf(s[0], s[1])), sink2);
                float p[2]; p[0] = __builtin_amdgcn_exp2f(s[0] - mx); p[1] = __builtin_amdgcn_exp2f(s[1] - mx);
                const float l = wave_sum(p[0] + p[1]) + __builtin_amdgcn_exp2f(sink2 - mx);
                float o = 0.f;
#pragma unroll
                for (int c = 0; c < 2; ++c) { const int kv0 = t - 127 + 64 * c; const bf16_t* vp = qkv + (size_t)(b * SEQ + kv0) * NQKV + VS_OFF + kvh * 64 + lane;
                    for (int kk = 0; kk < 64; ++kk) { if (kv0 + kk >= 0) { const float pk = __uint_as_float(__builtin_amdgcn_readlane(__float_as_uint(p[c]), kk)); o += pk * bf1(vp[(ptrdiff_t)kk * NQKV]); } } }
                yref[(size_t)m * DM + hh * 64 + lane] = (bf16_t)(cvt_pk_bf16(o / l, 0.f) & 0xffffu);
            }
            {
                const int qb = t >> 8; float qf[64]; load_q64(qkv + (size_t)m * NQKV + QM_OFF + hh * 64, qf);
                const float ql = bf1(qkv[(size_t)m * NQKV + QM_OFF + hh * 64 + lane]);
                float g[15];
#pragma unroll
                for (int j = 0; j < 15; ++j) { g[j] = -INFINITY; if (j < qb) g[j] = wave_sum(ql * (kmean[(size_t)(b * 16 + j) * 1024 + hh * 64 + lane] + kmean[(size_t)(b * 16 + j) * 1024 + 512 + hh * 64 + lane]) * (1.0f / 256.0f)); }
                int blk[4]; blk[0] = qb; blk[1] = -1; blk[2] = -1; blk[3] = -1;
                { float best = -INFINITY;
#pragma unroll
                  for (int j = 0; j < 15; ++j) if (g[j] > best) { best = g[j]; blk[1] = j; }
                  best = -INFINITY;
#pragma unroll
                  for (int j = 0; j < 15; ++j) if (j != blk[1] && g[j] > best) { best = g[j]; blk[2] = j; }
                  best = -INFINITY;
#pragma unroll
                  for (int j = 0; j < 15; ++j) if (j != blk[1] && j != blk[2] && g[j] > best) { best = g[j]; blk[3] = j; } }
                float s[16]; float mx = -1e30f;
#pragma unroll
                for (int bi = 0; bi < 4; ++bi)
#pragma unroll
                    for (int c = 0; c < 4; ++c) { float sv = -1e30f;
                        if (blk[bi] >= 0) { const int kv = blk[bi] * 256 + 64 * c + lane; const int dist = t - kv;
                            const float d = dot64(qkv + (size_t)(b * SEQ + kv) * NQKV + KM_OFF + hh * 64, qf);
                            sv = dist >= 0 ? d + tabn[(8 + hh) * 128 + (dist < 127 ? dist : 127)] : -1e30f; }
                        s[bi * 4 + c] = sv; mx = fmaxf(mx, sv); }
                mx = wave_max(mx); float ls = 0.f;
#pragma unroll
                for (int i = 0; i < 16; ++i) { s[i] = __builtin_amdgcn_exp2f(s[i] - mx); ls += s[i]; }
                const float l = wave_sum(ls); float o = 0.f;
#pragma unroll
                for (int bi = 0; bi < 4; ++bi)
#pragma unroll
                    for (int c = 0; c < 4; ++c) { if (blk[bi] >= 0) { const int kv0 = blk[bi] * 256 + 64 * c; const bf16_t* vp = qkv + (size_t)(b * SEQ + kv0) * NQKV + VM_OFF + hh * 64 + lane;
                            for (int kk = 0; kk < 64; ++kk) { if (kv0 + kk <= t) { const float pk = __uint_as_float(__builtin_amdgcn_readlane(__float_as_uint(s[bi * 4 + c]), kk)); o += pk * bf1(vp[(size_t)kk * NQKV]); } } } }
                yref[(size_t)m * DM + 512 + hh * 64 + lane] = (bf16_t)(cvt_pk_bf16(o / l, 0.f) & 0xffffu);
            }
        }

        }
        __syncthreads();
#endif
        for (int vw = vcu; vw < 256; vw += G) {
            {
                const int b = vw >> 4, hp = (vw >> 2) & 3, j4 = vw & 3;
                const bf16_t* base = qkv + (size_t)b * SEQ * NQKV; bf16x8 qrm[4];
#pragma unroll 1
                for (int hh = 0; hh < 2; ++hh) { const int h = 2 * hp + hh;
                    __syncthreads();
                    for (int i = tid; i < 15 * 64; i += 512) { const float* kp = kmean + (size_t)(b * 16 + (i >> 6)) * 1024 + h * 64 + (i & 63); kml[i] = (kp[0] + kp[512]) * (1.0f / 256.0f); }
                    __syncthreads();
                    int slot0 = 0;
                    for (int i = 0; i < 4; ++i) { const int s = j4 + 4 * (i >> 1), qb = (i & 1) ? 15 - s : s; const int in = i + 1, sn = j4 + 4 * (in >> 1), qbn = (in & 1) ? 15 - sn : sn;
                        att::attn_unit<1, 8>(base + (size_t)qb * 256 * NQKV + QM_OFF + h * 64, base + KM_OFF + h * 64, base + VM_OFF + h * 64,
                                             ybuf + ((size_t)b * SEQ + qb * 256) * DM + 512 + h * 64, 4 * qb + 4, 256 * qb, tabM + h * 768, kml, nullptr, 0, shm,
                                             qrm, i == 0, i < 3, base + (size_t)(qbn & 15) * 256 * NQKV + QM_OFF + h * 64, base + KM_OFF + h * 64, base + VM_OFF + h * 64, 0, slot0); } }
            }
            {
                const int bk = vw >> 3, b = bk >> 1, kvh = bk & 1;
                const bf16_t* base = qkv + (size_t)b * SEQ * NQKV;
                bf16x8 qrs[4]; int slot0s = 0;
                for (int i = 0; i < 8; ++i) { const int jb = (vw & 7) * 8 + i, T0 = jb - 2, T1 = T0 + 1;
                    att::attn_unit<0, 8>(base + (size_t)jb * 64 * NQKV + QS_OFF + kvh * 256, base + (ptrdiff_t)T0 * 64 * NQKV + KS_OFF + kvh * 64, base + (ptrdiff_t)T0 * 64 * NQKV + VS_OFF + kvh * 64,
                                         ybuf + ((size_t)b * SEQ + jb * 64) * DM + kvh * 256, 3, 128, tabS + kvh * 4 * 320, kml, a.sinks + kvh * 4, T0 < 0 ? -T0 : 0, shm,
                                         qrs, i == 0, i < 7, base + (size_t)(jb + 1) * 64 * NQKV + QS_OFF + kvh * 256, base + (ptrdiff_t)T1 * 64 * NQKV + KS_OFF + kvh * 64, base + (ptrdiff_t)T1 * 64 * NQKV + VS_OFF + kvh * 64, T1 < 0 ? -T1 : 0, slot0s); }
            }
        }
#if PROBE_ATTN
        xcd_barrier(bar);
        { bf16_t* const yref = (bf16_t*)(ws + WS_PROBE); const size_t nth = (size_t)G * 512, t0 = (size_t)vcu * 512 + tid;
          for (size_t i = t0; i < (size_t)MTOK * DM / 2; i += nth) { const int n_ = *(const unsigned short*)(ybuf + 2 * i); const unsigned r_ = *(const unsigned*)(yref + 2 * i);
              *(unsigned*)(yref + 2 * i) = cvt_pk_bf16(__builtin_amdgcn_cvt_f32_fp8(n_, 0) * (1.0f / 64.0f) - bf_lo(r_), __builtin_amdgcn_cvt_f32_fp8(n_, 1) * (1.0f / 64.0f) - bf_hi(r_)); } }
#endif
    }
    SEAM(3);

    if (IN(4)) {
        ProbBranch P; P.KB = 512; P.A = (const char*)ybuf; P.WaT = (const char*)wa_t; P.WbT = (const char*)wb_t; P.S.init(MTOK, DM, G, bx); P.gates = gates; P.merged = merged;
        pg8::gemm_phase<ProbBranch>(lds, P);
    }
    SEAM(4);

    if (IN(5)) {
        ProbOut P; P.KB = DM; P.A = (const char*)merged; P.Bt = (const char*)wo_t; P.S.init(MTOK, DM, G, bx); P.h = hbuf;
        pg8::gemm_phase<ProbOut>(lds, P);
    }
    SEAM(5);

    if (IN(6)) {
        constexpr int WRS = 2064;
        for (int i = tid; i < 48 * 128; i += 512) { const int n = i >> 7, c = i & 127; *(LAS u32x4*)(lds + n * WRS + c * 16) = *(const u32x4*)(wr_t + (size_t)n * DM + c * 8); }
        LAS float* lg = (LAS float*)(lds + 100 * 1024) + wave * (16 * 52);
        LAS int* hist = (LAS int*)(lds + MOE_OFF); LAS int* hbase = hist + 32;
        f32x4 gn[4], bs[4];
#pragma unroll
        for (int j = 0; j < 4; ++j) { gn[j] = *(const f32x4*)(a.g1 + 4 * lane + 256 * j); bs[j] = *(const f32x4*)(a.b1 + 4 * lane + 256 * j); }
        __syncthreads();
        const int niter = (512 + G - 1) / G;
        for (int itr = 0; itr < niter; ++itr) {
            const int wb = itr * G + vcu; const bool act_wg = wb < 512;
            if (tid < 32) hist[tid] = 0;
            __syncthreads();
            int e1 = 0, e2 = 0, rk1 = 0, rk2 = 0, tok = 0; float w1 = 0.f, w2 = 0.f;
            if (act_wg) {
                const int row0 = (wb * 8 + wave) * 16;
                for (int r = 0; r < 16; ++r) { const size_t ro = (size_t)(row0 + r) * DM + 4 * lane; f32x4 v[4]; float s = 0.f;
#pragma unroll
                    for (int j = 0; j < 4; ++j) { const int hw = *(const int*)(hbuf + ro + 256 * j); const f32x4 xv = ldnt((const f32x4*)(a.x + ro + 256 * j));
                        v[j] = xv * ALPHA + (f32x4){fp8_at(hw, 0), fp8_at(hw, 1), fp8_at(hw, 2), fp8_at(hw, 3)} * (1.0f / 1024.0f); s += (v[j][0] + v[j][1]) + (v[j][2] + v[j][3]); }
                    const float mean = wave_sum(s) * (1.0f / DM); float s2 = 0.f;
#pragma unroll
                    for (int j = 0; j < 4; ++j) { v[j] = v[j] - mean; s2 += (v[j][0] * v[j][0] + v[j][1] * v[j][1]) + (v[j][2] * v[j][2] + v[j][3] * v[j][3]); }
                    const float rstd = 1.0f / sqrtf(wave_sum(s2) * (1.0f / DM) + LN_EPS);
#pragma unroll
                    for (int j = 0; j < 4; ++j) { const f32x4 o = v[j] * rstd * gn[j] + bs[j]; u32x2 w; w.x = cvt_pk_bf16(o[0], o[1]); w.y = cvt_pk_bf16(o[2], o[3]); *(u32x2*)(x1 + ro + 256 * j) = w;
                        *(unsigned*)(x1f8 + ro + 256 * j) = pk4_fp8(clampf(o[0] * 4.0f, -448.f, 448.f), clampf(o[1] * 4.0f, -448.f, 448.f), clampf(o[2] * 4.0f, -448.f, 448.f), clampf(o[3] * 4.0f, -448.f, 448.f)); } }
                asm volatile("s_waitcnt vmcnt(0)" ::: "memory");
                f32x4 ac[3]; ac[0] = (f32x4){0.f, 0.f, 0.f, 0.f}; ac[1] = ac[0]; ac[2] = ac[0];
                const bf16_t* arow = x1 + (size_t)(row0 + (lane & 15)) * DM + 8 * (lane >> 4);
                const LAS unsigned char* brow = lds + (lane & 15) * WRS + (lane >> 4) * 16;
#pragma unroll 8
                for (int s = 0; s < 32; ++s) { const bf16x8 af = *(const bf16x8*)(arow + 32 * s);
#pragma unroll
                    for (int c = 0; c < 3; ++c) { const bf16x8 bfr = *(const LAS bf16x8*)(brow + c * 16 * WRS + s * 64); ac[c] = __builtin_amdgcn_mfma_f32_16x16x32_bf16(bfr, af, ac[c], 0, 0, 0); } }
#pragma unroll
                for (int c = 0; c < 3; ++c)
#pragma unroll
                    for (int r = 0; r < 4; ++r) lg[(lane & 15) * 52 + 16 * c + 4 * (lane >> 4) + r] = ac[c][r];
                asm volatile("s_waitcnt lgkmcnt(0)" ::: "memory");
                if (lane < 16) {
                    const LAS float* L = lg + lane * 52; tok = row0 + lane;
                    float gl[4];
#pragma unroll
                    for (int i = 0; i < 4; ++i) gl[i] = L[i] + a.bgr[i];
                    int gi = 0; float gm = gl[0];
#pragma unroll
                    for (int i = 1; i < 4; ++i) if (gl[i] > gm) { gm = gl[i]; gi = i; }
                    float gs = 0.f;
#pragma unroll
                    for (int i = 0; i < 4; ++i) gs += __expf(gl[i] - gm);
                    const float gp = 1.0f / gs;
                    float el[8];
#pragma unroll
                    for (int i = 0; i < 8; ++i) el[i] = L[4 + 8 * gi + i] + a.ber[8 * gi + i];
                    int i1 = 0; float t1 = el[0];
#pragma unroll
                    for (int i = 1; i < 8; ++i) if (el[i] > t1) { t1 = el[i]; i1 = i; }
                    int i2 = -1; float t2 = -INFINITY;
#pragma unroll
                    for (int i = 0; i < 8; ++i) if (i != i1 && el[i] > t2) { t2 = el[i]; i2 = i; }
                    w1 = gp / (1.0f + __expf(t2 - t1)); w2 = gp - w1;
                    e1 = 8 * gi + i1; e2 = 8 * gi + i2;
                    rk1 = __hip_atomic_fetch_add(hist + e1, 1, __ATOMIC_RELAXED, __HIP_MEMORY_SCOPE_WORKGROUP);
                    rk2 = __hip_atomic_fetch_add(hist + e2, 1, __ATOMIC_RELAXED, __HIP_MEMORY_SCOPE_WORKGROUP);
                }
            }
            __syncthreads();
            if (tid < 32) { const int c = hist[tid]; hbase[tid] = c ? (int)__hip_atomic_fetch_add(ctl + CW_CNT + tid, (unsigned)c, RLX_AGENT) : 0; }
            __syncthreads();
            if (act_wg && lane < 16) {
                (void)__hip_atomic_exchange((unsigned long long*)(list + (size_t)e1 * MTOK + hbase[e1] + rk1), (unsigned long long)((unsigned)tok * 2u) | ((unsigned long long)__float_as_uint(w1) << 32), RLX_AGENT);
                (void)__hip_atomic_exchange((unsigned long long*)(list + (size_t)e2 * MTOK + hbase[e2] + rk2), (unsigned long long)((unsigned)tok * 2u + 1u) | ((unsigned long long)__float_as_uint(w2) << 32), RLX_AGENT);
            }
            __syncthreads();
        }
    }
    SEAM(6);

    MoeTab MT; MT.cnt = (const LAS int*)(lds + MOE_OFF); MT.pre = MT.cnt + 32; MT.te = (const LAS unsigned char*)(MT.pre + 36); MT.G = G; MT.vcu = vcu; MT.total_units = 0;
    if (IN(7) || IN(8)) {
        LAS int* mc = (LAS int*)(lds + MOE_OFF); LAS int* mp = mc + 32; LAS unsigned char* mt = (LAS unsigned char*)(mp + 36);
        __syncthreads();
        if (wave == 0) {
            const int c = (lane < NEXP) ? (int)__hip_atomic_load(ctl + CW_CNT + (lane & 31), RLX_AGENT) : 0; const int ntl = (c + 255) >> 8;
            int incl = ntl;
#pragma unroll
            for (int o = 1; o < 32; o <<= 1) { const int t = __shfl_up(incl, o); if (lane >= o) incl += t; }
            const int p = incl - ntl;
            if (lane < NEXP) { mc[lane] = c; mp[lane] = p; for (int k = 0; k < ntl; ++k) mt[p + k] = (unsigned char)lane; }
            if (lane == NEXP - 1) mp[32] = incl; }
        __syncthreads();
        MT.total_units = __builtin_amdgcn_readfirstlane(MT.pre[32]) * 4;
    }

    if (IN(7)) {
        ProbGateUp P; P.KB = DM; P.A = (const char*)x1f8; P.Bt = (const char*)gu_t; P.T = MT; P.list = list; P.act = act;
        pg8::gemm_phase<ProbGateUp>(lds, P);
    }
    SEAM(7);

    if (IN(8)) {
        ProbDown P; P.KB = DEXP; P.A = (const char*)act; P.Bt = (const char*)wd_t; P.T = MT; P.list = list; P.ys = ys;
        pg8::gemm_phase<ProbDown>(lds, P);
    }
    SEAM(8);

    if (IN(9)) {
        f32x4 gn[4], bs[4];
#pragma unroll
        for (int j = 0; j < 4; ++j) { gn[j] = *(const f32x4*)(a.g2 + 4 * lane + 256 * j); bs[j] = *(const f32x4*)(a.b2 + 4 * lane + 256 * j); }
        for (int row = gw; row < MTOK; row += NGW) { const size_t ro = (size_t)row * DM + 4 * lane; const size_t yo = (size_t)(2 * row) * DM + 4 * lane; f32x4 v[4]; float s = 0.f;
#pragma unroll
            for (int j = 0; j < 4; ++j) { const u32x2 xw = *(const u32x2*)(x1 + ro + 256 * j); const int y0 = *(const int*)(ys + yo + 256 * j), y1 = *(const int*)(ys + yo + DM + 256 * j);
                constexpr float YS = 1.0f / 128.0f;
                v[j][0] = ALPHA * bf_lo(xw.x) + (fp8_at(y0, 0) + fp8_at(y1, 0)) * YS; v[j][1] = ALPHA * bf_hi(xw.x) + (fp8_at(y0, 1) + fp8_at(y1, 1)) * YS;
                v[j][2] = ALPHA * bf_lo(xw.y) + (fp8_at(y0, 2) + fp8_at(y1, 2)) * YS; v[j][3] = ALPHA * bf_hi(xw.y) + (fp8_at(y0, 3) + fp8_at(y1, 3)) * YS;
                s += (v[j][0] + v[j][1]) + (v[j][2] + v[j][3]); }
            const float mean = wave_sum(s) * (1.0f / DM); float s2 = 0.f;
#pragma unroll
            for (int j = 0; j < 4; ++j) { v[j] = v[j] - mean; s2 += (v[j][0] * v[j][0] + v[j][1] * v[j][1]) + (v[j][2] * v[j][2] + v[j][3] * v[j][3]); }
            const float rstd = 1.0f / sqrtf(wave_sum(s2) * (1.0f / DM) + LN_EPS);
#pragma unroll
            for (int j = 0; j < 4; ++j) { f32x4 o_ = v[j] * rstd * gn[j] + bs[j];
#if PROBE_ATTN
                { const bf16_t* yr = (const bf16_t*)(ws + WS_PROBE); const int col = 4 * lane + 256 * j;
                  if (col >= PROBE_LO && col < PROBE_HI) { const u32x2 r_ = *(const u32x2*)(yr + ro + 256 * j);
                      o_[0] += PROBE_AMP * bf_lo(r_.x); o_[1] += PROBE_AMP * bf_hi(r_.x); o_[2] += PROBE_AMP * bf_lo(r_.y); o_[3] += PROBE_AMP * bf_hi(r_.y); } }
#endif
                st_wt16(a.out + ro + 256 * j, __builtin_bit_cast(u32x4, o_)); } }
        if (!sat_ok) { __syncthreads(); asm volatile("s_waitcnt vmcnt(0)" ::: "memory"); a.out[(size_t)vcu * 512 + tid] = __builtin_nanf(""); }
    }
#undef IN
#undef SEAM
}

extern "C" void kernel_launch(void* const* d_in, const int* in_sizes, int n_in, void* d_out, int out_size, void* d_ws, size_t ws_size, hipStream_t stream) {
    static int grid = 0;
    if (grid == 0) {
        if (n_in != 19 || in_sizes[0] != MTOK * DM || out_size != MTOK * DM || ws_size < WS_END) { fprintf(stderr, "kernel_launch: unexpected shapes (n_in %d, in0 %d, out %d, ws %zu)\n", n_in, n_in > 0 ? in_sizes[0] : -1, out_size, ws_size); grid = -1; return; }
        int dev = 0, cus = 0, per_cu = 0;
        if (hipGetDevice(&dev) != hipSuccess || hipDeviceGetAttribute(&cus, hipDeviceAttributeMultiprocessorCount, dev) != hipSuccess) { grid = -1; return; }
        if (hipFuncSetAttribute((const void*)fwd_kernel, hipFuncAttributeMaxDynamicSharedMemorySize, LDS_BYTES) != hipSuccess) { fprintf(stderr, "kernel_launch: hipFuncSetAttribute failed\n"); grid = -1; return; }
        if (hipOccupancyMaxActiveBlocksPerMultiprocessor(&per_cu, (const void*)fwd_kernel, 512, LDS_BYTES) != hipSuccess || per_cu < 1) { fprintf(stderr, "kernel_launch: occupancy query reports %d\n", per_cu); }
        (void)hipGetLastError();
        grid = cus;
    }
    if (grid < 0) return;
    if (hipMemsetAsync((char*)d_ws + WS_CTL, 0, CTL_ZERO_BYTES, stream) != hipSuccess) return;
    Args a{};
    a.x = (const float*)d_in[0]; a.w_in = (const float*)d_in[1]; a.b_in = (const float*)d_in[2]; a.sinks = (const float*)d_in[3]; a.rel = (const float*)d_in[4];
    a.wa = (const float*)d_in[5]; a.wb = (const float*)d_in[6]; a.wo = (const float*)d_in[7]; a.g1 = (const float*)d_in[8]; a.b1 = (const float*)d_in[9];
    a.wgr = (const float*)d_in[10]; a.bgr = (const float*)d_in[11]; a.wer = (const float*)d_in[12]; a.ber = (const float*)d_in[13];
    a.wg = (const float*)d_in[14]; a.wu = (const float*)d_in[15]; a.wd = (const float*)d_in[16]; a.g2 = (const float*)d_in[17]; a.b2 = (const float*)d_in[18];
    a.out = (float*)d_out; a.ws = (unsigned char*)d_ws; a.pad = 0;
    if (MK_N_LAUNCHES == 1) { a.ph_lo = 0; a.ph_hi = NPHASE; a.li = 0; hipLaunchKernelGGL(fwd_kernel, dim3(grid), dim3(512), LDS_BYTES, stream, a); }
    else { for (int li = 0; li < NPHASE; ++li) for (int rep = 0; rep < (li == DUP_PHASE ? 2 : 1); ++rep) { a.ph_lo = li; a.ph_hi = li + 1; a.li = li; hipLaunchKernelGGL(fwd_kernel, dim3(grid), dim3(512), LDS_BYTES, stream, a); } }
    const hipError_t le = hipPeekAtLastError();
    if (le != hipSuccess) fprintf(stderr, "kernel_launch: launch failed: %s\n", hipGetErrorName(le));
}
```
